# Optimizing an MI355X kernel written in HIP

```python
import math
import jax, jax.numpy as jnp
from jax import lax
import numpy as np

D_MODEL = 1024
BATCH = 4
SEQ = 4096
DEPTH = 2

HEAD_DIM = 64
N_MIXERS = 2
DSW_GROUPS = ((128, 1), (512, 4), (2048, 16))
DSW_N_GROUPS = len(DSW_GROUPS)
DSW_HEADS_PER_GROUP = D_MODEL // (2 * HEAD_DIM)
DSW_HEADS = DSW_N_GROUPS * DSW_HEADS_PER_GROUP
DSW_OUT_WIDTH = DSW_HEADS_PER_GROUP * HEAD_DIM
MOBA_HEADS = D_MODEL // HEAD_DIM
MOBA_BLOCK = 256
MOBA_TOPK = 3
MOBA_Q_CHUNK = 32
D_FF = 4 * D_MODEL
REL_BUCKETS = 32
REL_MAX_DISTANCE = 2048
BIAS_HEADS = max(DSW_HEADS, MOBA_HEADS)

N_A_LAYERS = (DEPTH + 1) // 2
N_B_LAYERS = DEPTH // 2
EPS = 1e-6
NEG = -1e30
SCALE = HEAD_DIM ** -0.5

kernel_name = "hybrid_dilated_moba_sqrelu"


def rmsnorm(x, g):
    xf = x.astype(jnp.float32)
    y = xf * lax.rsqrt(jnp.mean(xf * xf, axis=-1, keepdims=True) + EPS)
    return (y * g.astype(jnp.float32)).astype(x.dtype)


def t5_bucket(dist):
    n = jnp.maximum(dist, 0)
    max_exact = REL_BUCKETS // 2
    nf = jnp.maximum(n, 1).astype(jnp.float32)
    large = max_exact + (jnp.log(nf / max_exact) / math.log(REL_MAX_DISTANCE / max_exact)
                         * (REL_BUCKETS - max_exact)).astype(jnp.int32)
    large = jnp.minimum(large, REL_BUCKETS - 1)
    return jnp.where(n < max_exact, n, large)


def softmax_attend(logits, v, eq):
    m = jnp.max(logits, axis=-1, keepdims=True)
    p = jnp.exp(logits - m)
    den = jnp.sum(p, axis=-1, keepdims=True)
    o = jnp.einsum(eq, p / den, v.astype(jnp.float32))
    return o, (m + jnp.log(den))[..., 0]


def dsw_group(q, k, v, rel_bias, col0, window, dilation):
    B, H, S, hd = q.shape
    n = window // dilation
    blk = n
    L = S // dilation
    nb = -(-L // blk)
    Lp = nb * blk

    def to_sub(t):
        t = t.reshape(B, H, L, dilation, hd).transpose(0, 1, 3, 2, 4)
        return jnp.pad(t, ((0, 0), (0, 0), (0, 0), (0, Lp - L), (0, 0)))

    def band(t):
        t = jnp.pad(t, ((0, 0), (0, 0), (0, 0), (blk, 0), (0, 0))).reshape(B, H, dilation, nb + 1, blk, hd)
        return jnp.concatenate([t[:, :, :, :-1], t[:, :, :, 1:]], axis=4)

    qs, ks, vs = to_sub(q), to_sub(k), to_sub(v)
    qb = qs.reshape(B, H, dilation, nb, blk, hd)
    kb, vb = band(ks), band(vs)
    logits = jnp.einsum('bhrnid,bhrnjd->bhrnij', qb, kb, preferred_element_type=jnp.float32) * SCALE

    i = jnp.arange(blk)[:, None]
    j = jnp.arange(2 * blk)[None, :]
    dist = blk + i - j
    in_band = (dist >= 0) & (dist <= n)
    first = (jnp.arange(nb) == 0)[:, None, None] & (j < blk)[None]
    mask = in_band[None] & ~first
    bias = rel_bias[t5_bucket(dist * dilation)][..., col0:col0 + H].transpose(2, 0, 1)
    logits = jnp.where(mask[None, None, None], logits + bias[None, :, None, None], NEG)

    o, lse = softmax_attend(logits, vb, 'bhrnij,bhrnjd->bhrnid')
    o = o.reshape(B, H, dilation, Lp, hd)[:, :, :, :L].transpose(0, 1, 3, 2, 4).reshape(B, H, S, hd)
    lse = lse.reshape(B, H, dilation, Lp)[..., :L].transpose(0, 1, 3, 2).reshape(B, H, S)
    return o, lse


def dsw_mixer(h, w_qkv, q_gain, k_gain, w_o, rel_bias):
    B, S, _ = h.shape
    G, Hg = DSW_N_GROUPS, DSW_HEADS_PER_GROUP
    qkv = (h @ w_qkv).reshape(B, S, 3, G, Hg, HEAD_DIM)
    q = rmsnorm(qkv[:, :, 0], q_gain)
    k = rmsnorm(qkv[:, :, 1], k_gain)
    v = qkv[:, :, 2]
    outs, lses = [], []
    for g, (window, dilation) in enumerate(DSW_GROUPS):
        o, lse = dsw_group(q[:, :, g].transpose(0, 2, 1, 3), k[:, :, g].transpose(0, 2, 1, 3),
                           v[:, :, g].transpose(0, 2, 1, 3), rel_bias, g * Hg, window, dilation)
        outs.append(o)
        lses.append(lse)
    wts = jax.nn.softmax(jnp.stack(lses), axis=0)
    o = jnp.einsum('gbhs,gbhsd->bshd', wts, jnp.stack(outs)).reshape(B, S, DSW_OUT_WIDTH)
    return o.astype(h.dtype) @ w_o


def gather_blocks(blocks, idx):
    return jax.vmap(jax.vmap(lambda bl, ix: bl[ix]))(blocks, idx)


def moba_mixer(h, w_qkv, q_gain, k_gain, w_o, rel_bias):
    B, S, _ = h.shape
    H, hd, blk = MOBA_HEADS, HEAD_DIM, MOBA_BLOCK
    qkv = (h @ w_qkv).reshape(B, S, 3, H, hd)
    q = rmsnorm(qkv[:, :, 0], q_gain).transpose(0, 2, 1, 3)
    k = rmsnorm(qkv[:, :, 1], k_gain).transpose(0, 2, 1, 3)
    v = qkv[:, :, 2].transpose(0, 2, 1, 3)
    nblk = -(-S // blk)
    Sp = nblk * blk
    pad = ((0, 0), (0, 0), (0, Sp - S), (0, 0))
    q, k, v = jnp.pad(q, pad), jnp.pad(k, pad), jnp.pad(v, pad)
    qb = q.reshape(B, H, nblk, blk, hd)
    kb = k.reshape(B, H, nblk, blk, hd)
    vb = v.reshape(B, H, nblk, blk, hd)
    pos = jnp.arange(Sp)
    qblk = pos // blk
    table_h = rel_bias[:, :H].T

    ii = jnp.arange(blk)
    own_bias = table_h[:, t5_bucket(ii[:, None] - ii[None, :])]
    lo = jnp.einsum('bhnid,bhnjd->bhnij', qb, kb, preferred_element_type=jnp.float32) * SCALE
    lo = jnp.where(ii[:, None] >= ii[None, :], lo + own_bias[None, :, None], NEG)
    o_own, lse_own = softmax_attend(lo, vb, 'bhnij,bhnjd->bhnid')
    o_own = o_own.reshape(B, H, Sp, hd)
    lse_own = lse_own.reshape(B, H, Sp)

    kmean = jnp.mean(kb.astype(jnp.float32), axis=3)
    gate = jnp.einsum('bhsd,bhnd->bhsn', q.astype(jnp.float32), kmean)
    past = jnp.arange(nblk)[None, :] < qblk[:, None]
    gate = jnp.where(past, gate, -jnp.inf)
    topk = min(MOBA_TOPK, nblk)
    _, sel = lax.top_k(gate, topk)
    sel_valid = sel < qblk[:, None]

    C = MOBA_Q_CHUNK
    nC = Sp // C

    def chunk(t):
        return jnp.moveaxis(t.reshape(B, H, nC, C, *t.shape[3:]), 2, 0)

    jj = jnp.arange(blk)
    head_ix = jnp.arange(H)[None, :, None, None]

    def attend(args):
        qc, selc, validc, posc = args
        flat = selc.reshape(B, H, C * topk)
        kg = gather_blocks(kb, flat).reshape(B, H, C, topk * blk, hd)
        vg = gather_blocks(vb, flat).reshape(B, H, C, topk * blk, hd)
        logits = jnp.einsum('bhcd,bhckd->bhck', qc, kg, preferred_element_type=jnp.float32) * SCALE
        kpos = (selc[..., None] * blk + jj).reshape(B, H, C, topk * blk)
        bias = table_h[head_ix, t5_bucket(posc[None, None, :, None] - kpos)]
        valid = jnp.repeat(validc, blk, axis=-1)
        logits = jnp.where(valid, logits + bias, NEG)
        return softmax_attend(logits, vg, 'bhck,bhckd->bhcd')

    o_sel, lse_sel = lax.map(attend, (chunk(q), chunk(sel), chunk(sel_valid), pos.reshape(nC, C)))
    o_sel = jnp.moveaxis(o_sel, 0, 2).reshape(B, H, Sp, hd)
    lse_sel = jnp.moveaxis(lse_sel, 0, 2).reshape(B, H, Sp)

    lse = jnp.logaddexp(lse_own, lse_sel)
    o = jnp.exp(lse_own - lse)[..., None] * o_own + jnp.exp(lse_sel - lse)[..., None] * o_sel
    o = o[:, :, :S].transpose(0, 2, 1, 3).reshape(B, S, H * hd)
    return o.astype(h.dtype) @ w_o


def sq_relu_mlp(h, w1, w2):
    return jnp.square(jax.nn.relu(h @ w1)) @ w2


def setup_inputs(seed: int = 0) -> dict:
    key = jax.random.key(seed)
    ks = jax.random.split(key, 16)
    D = D_MODEL
    nrm = lambda k, shape, s: jax.random.normal(k, shape, jnp.float32) * s
    a_qkv_cols = 3 * DSW_HEADS * HEAD_DIM
    b_qkv_cols = 3 * MOBA_HEADS * HEAD_DIM
    return {
        "x": nrm(ks[0], (BATCH, SEQ, D), 1.0),
        "rel_bias": nrm(ks[1], (REL_BUCKETS, BIAS_HEADS), 0.3),
        "norm_mix": 1.0 + nrm(ks[2], (DEPTH, D), 0.02),
        "norm_ffn": 1.0 + nrm(ks[3], (DEPTH, D), 0.02),
        "a_w_qkv": nrm(ks[4], (N_A_LAYERS, D, a_qkv_cols), D ** -0.5),
        "a_q_gain": 1.0 + nrm(ks[5], (N_A_LAYERS, HEAD_DIM), 0.02),
        "a_k_gain": 1.0 + nrm(ks[6], (N_A_LAYERS, HEAD_DIM), 0.02),
        "a_w_o": nrm(ks[7], (N_A_LAYERS, DSW_OUT_WIDTH, D), DSW_OUT_WIDTH ** -0.5),
        "b_w_qkv": nrm(ks[8], (N_B_LAYERS, D, b_qkv_cols), D ** -0.5),
        "b_q_gain": 1.0 + nrm(ks[9], (N_B_LAYERS, HEAD_DIM), 0.02),
        "b_k_gain": 1.0 + nrm(ks[10], (N_B_LAYERS, HEAD_DIM), 0.02),
        "b_w_o": nrm(ks[11], (N_B_LAYERS, MOBA_HEADS * HEAD_DIM, D), (MOBA_HEADS * HEAD_DIM) ** -0.5),
        "ffn_w1": nrm(ks[12], (DEPTH, D, D_FF), D ** -0.5),
        "ffn_w2": nrm(ks[13], (DEPTH, D_FF, D), 0.5 * D_FF ** -0.5),
    }


def reference(x, rel_bias, norm_mix, norm_ffn, a_w_qkv, a_q_gain, a_k_gain, a_w_o,
              b_w_qkv, b_q_gain, b_k_gain, b_w_o, ffn_w1, ffn_w2):
    h = x
    for i in range(DEPTH):
        u = rmsnorm(h, norm_mix[i])
        li = i // N_MIXERS
        if i % N_MIXERS == 0:
            h = h + dsw_mixer(u, a_w_qkv[li], a_q_gain[li], a_k_gain[li], a_w_o[li], rel_bias)
        else:
            h = h + moba_mixer(u, b_w_qkv[li], b_q_gain[li], b_k_gain[li], b_w_o[li], rel_bias)
        h = h + sq_relu_mlp(rmsnorm(h, norm_ffn[i]), ffn_w1[i], ffn_w2[i])
    return h
```

```cpp
#include <hip/hip_runtime.h>
#include <cstdio>
#include <cstdint>

#define LAS __attribute__((address_space(3)))
#define GAS __attribute__((address_space(1)))
typedef unsigned short bf16_t;
typedef short bf16x8 __attribute__((ext_vector_type(8)));
typedef short s16x4 __attribute__((ext_vector_type(4)));
typedef float f32x4 __attribute__((ext_vector_type(4)));
typedef float f32x2 __attribute__((ext_vector_type(2)));
typedef float f32x16 __attribute__((ext_vector_type(16)));
typedef unsigned u32x4 __attribute__((ext_vector_type(4)));
typedef unsigned u32x2 __attribute__((ext_vector_type(2)));
typedef __bf16 bf16x2_t __attribute__((ext_vector_type(2)));

constexpr int BATCH = 4, SEQ = 4096, DM = 1024, MTOK = BATCH * SEQ, FF = 4096, HD = 64;
constexpr int NQKV0 = 4608, NO0 = 512, NQKV1 = 3072, NO1 = 1024;
constexpr float EPS = 1e-6f, LOG2E = 1.4426950408889634f, QSCALE = 0.125f * LOG2E, NEGV = -1e30f;
constexpr int TBLB_N = 4352, TBLA_N = 640, TOFF = 255;

__device__ __forceinline__ unsigned cvtpk(float lo, float hi) { f32x2 v = {lo, hi}; bf16x2_t b = __builtin_convertvector(v, bf16x2_t); return __builtin_bit_cast(unsigned, b); }
__device__ __forceinline__ float bf2f(unsigned short h) { return __builtin_bit_cast(float, (unsigned)h << 16); }
__device__ __forceinline__ float rsq(float x) { return __builtin_amdgcn_rsqf(x); }

namespace pg8 {
constexpr int BM = 256, BK = 64, HALF = 128, HTB = HALF * BK * 2, STAGE_BYTES = 8 * HTB, NXCD = 8, WGM = 4;
__host__ __device__ __forceinline__ int lds_byte(int r, int c) { const int st = (r >> 4) * 2 + (c >> 5), rr = r & 15, cc = c & 31, ob = rr * 64 + cc * 2; return st * 1024 + (ob ^ (((ob >> 9) & 1) << 5)); }
__host__ __device__ __forceinline__ void stage_rc(int b, int& R, int& C) { const int st = b / 1024, sb = b % 1024, swz = sb ^ (((sb >> 9) & 1) << 5); R = (st >> 1) * 16 + swz / 64; C = (st & 1) * 32 + (swz % 64) / 2; }
__host__ __device__ __forceinline__ int perm32(int rho) { const int n = rho >> 4, i = rho & 15; return 8 * (i >> 2) + 4 * n + (i & 3); }
struct Unit { int pm, pn; };
struct Gemm { const bf16_t* A; const bf16_t* Bt; int M, N, K; };
struct StaticOrder {
    int nM, nN, nwg, G, c;
    __host__ __device__ void init(int M, int N, int G_, int c_) { nM = M / BM; nN = N / BM; nwg = nM * nN; G = G_; c = c_; }
    __host__ __device__ bool next(int i, Unit& u) const {
        const long L = (long)i * G + c; if (L >= nwg) return false;
        int wgid = (int)L; { const int q = nwg / NXCD, r = nwg % NXCD, xcd = wgid % NXCD, off = wgid / NXCD; wgid = (xcd < r ? xcd * (q + 1) : r * (q + 1) + (xcd - r) * q) + off; }
        const int nig = WGM * nN, gid = wgid / nig, fm = gid * WGM, gsz = (nM - fm) < WGM ? (nM - fm) : WGM;
        u.pm = fm + ((wgid % nig) % gsz); u.pn = (wgid % nig) / gsz; return true;
    }
};

struct EpiQKV {
    static constexpr bool PERM = true, AFTER_DRAIN = false;
    int layer; const float* ssp; const float* gq; const float* gk; bf16_t* dst; float* kmp;
    __device__ __forceinline__ void operator()(const f32x4 (&acc)[2][2][4][2], const Unit& u, int wr, int wc, int fr, int fq) const {
        const int pn = u.pn, pm = u.pm; int kind, hh, g = 0;
        if (layer == 0) { kind = pn / 6; const int rem = pn % 6; g = rem >> 1; hh = (rem & 1) * 4 + wc; } else { kind = pn >> 2; hh = (pn & 3) * 4 + wc; }
        f32x4 gv[2][2]; const float* gp = (kind == 0) ? gq : gk;
#pragma unroll
        for (int bj = 0; bj < 2; ++bj)
#pragma unroll
            for (int n = 0; n < 2; ++n) gv[bj][n] = *(const f32x4*)(gp + 32 * bj + 8 * fq + 4 * n);
        f32x4 cs[2][2];
#pragma unroll
        for (int bj = 0; bj < 2; ++bj)
#pragma unroll
            for (int n = 0; n < 2; ++n) cs[bj][n] = (f32x4){0.f, 0.f, 0.f, 0.f};
        const bool km = (layer == 1 && kind == 1);
#pragma unroll
        for (int ai = 0; ai < 2; ++ai)
#pragma unroll
            for (int m = 0; m < 4; ++m) {
                const int row = pm * BM + ai * HALF + wr * 64 + m * 16 + fr;
                const f32x4 pv = *(const f32x4*)(ssp + (size_t)row * 4);
                const float r = rsq(((pv[0] + pv[1]) + (pv[2] + pv[3])) * (1.f / 1024.f) + EPS);
                f32x4 v[2][2];
#pragma unroll
                for (int bj = 0; bj < 2; ++bj)
#pragma unroll
                    for (int n = 0; n < 2; ++n) v[bj][n] = acc[ai][bj][m][n] * r;
                if (kind < 2) {
                    float s = 0.f;
#pragma unroll
                    for (int bj = 0; bj < 2; ++bj)
#pragma unroll
                        for (int n = 0; n < 2; ++n) { const f32x4 x = v[bj][n]; s += (x[0] * x[0] + x[1] * x[1]) + (x[2] * x[2] + x[3] * x[3]); }
                    s += __shfl_xor(s, 16); s += __shfl_xor(s, 32);
                    float rn = rsq(s * (1.f / 64.f) + EPS); if (kind == 0) rn *= QSCALE;
#pragma unroll
                    for (int bj = 0; bj < 2; ++bj)
#pragma unroll
                        for (int n = 0; n < 2; ++n) { v[bj][n] = v[bj][n] * rn * gv[bj][n]; if (km) cs[bj][n] += v[bj][n]; }
                }
                const int b = row >> 12, t = row & 4095; size_t off;
                if (layer == 0) { const int sh = 2 * g, c = t & ((1 << sh) - 1), l = t >> sh;
                    off = (size_t)(kind * 3 + g) * ((size_t)MTOK * 512) + ((((size_t)((b << sh) + c)) * 8 + hh) * (size_t)(4096 >> sh) + l) * 64; }
                else off = (size_t)kind * ((size_t)MTOK * 1024) + (((size_t)b * 16 + hh) * 4096 + t) * 64;
                bf16_t* p = dst + off + 8 * fq;
#pragma unroll
                for (int bj = 0; bj < 2; ++bj) { u32x4 w; w.x = cvtpk(v[bj][0][0], v[bj][0][1]); w.y = cvtpk(v[bj][0][2], v[bj][0][3]); w.z = cvtpk(v[bj][1][0], v[bj][1][1]); w.w = cvtpk(v[bj][1][2], v[bj][1][3]);
                    *(u32x4*)(p + 32 * bj) = w; }
            }
        if (km) {
#pragma unroll
            for (int bj = 0; bj < 2; ++bj)
#pragma unroll
                for (int n = 0; n < 2; ++n)
#pragma unroll
                    for (int e = 0; e < 4; ++e) { float x = cs[bj][n][e]; x += __shfl_xor(x, 1); x += __shfl_xor(x, 2); x += __shfl_xor(x, 4); x += __shfl_xor(x, 8); cs[bj][n][e] = x; }
            if (fr == 0) { const int b = pm >> 4, nb = pm & 15; float* kp = kmp + ((((size_t)wr * BATCH + b) * 16 + nb) * 16 + hh) * 64 + 8 * fq;
#pragma unroll
                for (int bj = 0; bj < 2; ++bj)
#pragma unroll
                    for (int n = 0; n < 2; ++n) *(f32x4*)(kp + 32 * bj + 4 * n) = cs[bj][n]; }
        }
    }
};
struct EpiUp {
    static constexpr bool PERM = true, AFTER_DRAIN = false;
    const float* ssp; bf16_t* H;
    __device__ __forceinline__ void operator()(const f32x4 (&acc)[2][2][4][2], const Unit& u, int wr, int wc, int fr, int fq) const {
#pragma unroll
        for (int ai = 0; ai < 2; ++ai)
#pragma unroll
            for (int m = 0; m < 4; ++m) {
                const int row = u.pm * BM + ai * HALF + wr * 64 + m * 16 + fr;
                const f32x4 pv = *(const f32x4*)(ssp + (size_t)row * 4);
                const float r = rsq(((pv[0] + pv[1]) + (pv[2] + pv[3])) * (1.f / 1024.f) + EPS);
                bf16_t* rowp = H + (size_t)row * FF + u.pn * BM + wc * 32 + 8 * fq;
#pragma unroll
                for (int bj = 0; bj < 2; ++bj) { f32x4 v0 = acc[ai][bj][m][0] * r, v1 = acc[ai][bj][m][1] * r;
#pragma unroll
                    for (int e = 0; e < 4; ++e) { const float a = fmaxf(v0[e], 0.f), b = fmaxf(v1[e], 0.f); v0[e] = a * a; v1[e] = b * b; }
                    u32x4 w; w.x = cvtpk(v0[0], v0[1]); w.y = cvtpk(v0[2], v0[3]); w.z = cvtpk(v1[0], v1[1]); w.w = cvtpk(v1[2], v1[3]);
                    *(u32x4*)(rowp + bj * HALF) = w; }
            }
    }
};
template <int MODE> struct EpiRes {
    static constexpr bool PERM = true, AFTER_DRAIN = true;
    const float* basef; float* out; bf16_t* hb; float* ssp;
    __device__ __forceinline__ void fused(f32x4 (&acc)[2][2][4][2], const Unit& u, int wr, int wc, int fr, int fq, LAS unsigned char* lds, int wid, int lane) const {
        LAS float* P = (LAS float*)lds;
        const int col0 = u.pn * BM + wc * 32 + 8 * fq;
#pragma unroll
        for (int ai = 0; ai < 2; ++ai)
#pragma unroll
            for (int m = 0; m < 4; ++m) {
                const int rl = ai * HALF + wr * 64 + m * 16 + fr; const size_t off = (size_t)(u.pm * BM + rl) * DM + col0; float s = 0.f;
                f32x4 bv[2][2];
#pragma unroll
                for (int bj = 0; bj < 2; ++bj) {
                    if (MODE == 0) { bv[bj][0] = *(const f32x4*)(basef + off + bj * HALF); bv[bj][1] = *(const f32x4*)(basef + off + bj * HALF + 4); }
                    else { const u32x4 w = *(const u32x4*)(hb + off + bj * HALF);
                        bv[bj][0] = (f32x4){__builtin_bit_cast(float, w.x << 16), __builtin_bit_cast(float, w.x & 0xffff0000u), __builtin_bit_cast(float, w.y << 16), __builtin_bit_cast(float, w.y & 0xffff0000u)};
                        bv[bj][1] = (f32x4){__builtin_bit_cast(float, w.z << 16), __builtin_bit_cast(float, w.z & 0xffff0000u), __builtin_bit_cast(float, w.w << 16), __builtin_bit_cast(float, w.w & 0xffff0000u)}; } }
#pragma unroll
                for (int bj = 0; bj < 2; ++bj) { const f32x4 h0 = bv[bj][0] + acc[ai][bj][m][0], h1 = bv[bj][1] + acc[ai][bj][m][1];
                    if (MODE == 2) { *(f32x4*)(out + off + bj * HALF) = h0; *(f32x4*)(out + off + bj * HALF + 4) = h1; }
                    else { u32x4 w; w.x = cvtpk(h0[0], h0[1]); w.y = cvtpk(h0[2], h0[3]); w.z = cvtpk(h1[0], h1[1]); w.w = cvtpk(h1[2], h1[3]); *(u32x4*)(hb + off + bj * HALF) = w;
                        s += ((h0[0] * h0[0] + h0[1] * h0[1]) + (h0[2] * h0[2] + h0[3] * h0[3])) + ((h1[0] * h1[0] + h1[1] * h1[1]) + (h1[2] * h1[2] + h1[3] * h1[3])); } }
                if (MODE != 2) { s += __shfl_xor(s, 16); s += __shfl_xor(s, 32); if (fq == 0) P[rl * 4 + wc] = s; }
                asm volatile("" ::: "memory");
            }
        if (MODE != 2) {
            asm volatile("s_waitcnt lgkmcnt(0)" ::: "memory"); __builtin_amdgcn_s_barrier(); asm volatile("" ::: "memory");
            const int t = wid * 64 + lane;
            if (t < 256) { const f32x4 p = *(const LAS f32x4*)(P + t * 4); ssp[(size_t)(u.pm * BM + t) * 4 + u.pn] = (p[0] + p[1]) + (p[2] + p[3]); }
        }
    }
};

template <class Epi, class Sched, bool ALIGN_EPI = false, bool SP2 = false>
__device__ __forceinline__ void gemm_phase(LAS unsigned char* lds, const Gemm g, const Sched& S, const Epi& E) {
    const int tid = threadIdx.x, wid = __builtin_amdgcn_readfirstlane(tid >> 6), lane = tid & 63, wr = wid >> 2, wc = wid & 3, fr = lane & 15, fq = lane >> 4;
    const int K = g.K, nt = K / BK;
    unsigned voffA[2], voffB[2];
#pragma unroll
    for (int i = 0; i < 2; ++i) { int R, C; stage_rc(tid * 16 + i * 8192, R, C); const int Rb = Epi::PERM ? ((R & ~31) + perm32(R & 31)) : R;
        voffA[i] = (unsigned)(R * K + C) * 2u; voffB[i] = (unsigned)(Rb * K + C) * 2u; }
    const size_t kstep = (size_t)(BK * 2);
    const size_t hstep = (size_t)HALF * K * 2;
    const size_t tstep = 2 * hstep;
    const unsigned ldsw = (unsigned)wid * 1024u;
    const int aoff = lds_byte(wr * 64 + fr, fq * 8), boff = lds_byte(wc * 32 + fr, fq * 8);
#define PG8_SA(b, h) (((b) * 2 + (h)) * HTB)
#define PG8_SB(b, h) ((4 + (b) * 2 + (h)) * HTB)
#define PG8_STAGE(bufoff, gbase, voff) do { _Pragma("unroll") for (int _i = 0; _i < 2; ++_i) \
        __builtin_amdgcn_global_load_lds((const unsigned*)((const char*)(gbase) + (voff)[_i]), (LAS unsigned*)(lds + (bufoff) + ldsw + _i * 8192), 16, 0, 0); } while (0)
#define PG8_LDA(dst, b, h) do { _Pragma("unroll") for (int m = 0; m < 4; ++m) _Pragma("unroll") for (int k = 0; k < 2; ++k) dst[m][k] = *(const LAS bf16x8*)(lds + PG8_SA(b, h) + aoff + m * 2048 + k * 1024); } while (0)
#define PG8_LDB(dst, b, h) do { _Pragma("unroll") for (int n = 0; n < 2; ++n) _Pragma("unroll") for (int k = 0; k < 2; ++k) dst[n][k] = *(const LAS bf16x8*)(lds + PG8_SB(b, h) + boff + n * 2048 + k * 1024); } while (0)
#define PG8_MMA(ai, bj, At, Bt) do { __builtin_amdgcn_s_setprio(1); _Pragma("unroll") for (int m = 0; m < 4; ++m) _Pragma("unroll") for (int n = 0; n < 2; ++n) _Pragma("unroll") for (int k = 0; k < 2; ++k) \
        acc[ai][bj][m][n] = __builtin_amdgcn_mfma_f32_16x16x32_bf16(Bt[n][k], At[m][k], acc[ai][bj][m][n], 0, 0, 0); __builtin_amdgcn_s_setprio(0); } while (0)
#define PG8_WAIT_V(n) asm volatile("s_waitcnt vmcnt(" #n ")" ::: "memory")
#define PG8_WAIT_L(n) asm volatile("s_waitcnt lgkmcnt(" #n ")" ::: "memory")
#define PG8_BAR __builtin_amdgcn_s_barrier()
#define PG8_SCHED __builtin_amdgcn_sched_barrier(0)
    Unit cur, nxt; int ui = 0;
    if (!S.next(0, cur)) return;
    f32x4 acc[2][2][4][2];
#pragma unroll
    for (int a = 0; a < 2; ++a)
#pragma unroll
        for (int b = 0; b < 2; ++b)
#pragma unroll
            for (int m = 0; m < 4; ++m)
#pragma unroll
                for (int n = 0; n < 2; ++n) acc[a][b][m][n] = (f32x4){0.f, 0.f, 0.f, 0.f};
    bf16x8 At[4][2], B0[2][2], B1[2][2];
    const char* cA = (const char*)g.A + (size_t)cur.pm * tstep; const char* cB = (const char*)g.Bt + (size_t)cur.pn * tstep;
    if constexpr (SP2) {
        PG8_STAGE(PG8_SB(0, 0), cB, voffB); PG8_STAGE(PG8_SB(0, 1), cB + hstep, voffB); PG8_STAGE(PG8_SA(0, 0), cA, voffA); PG8_STAGE(PG8_SA(0, 1), cA + hstep, voffA);
        if (wr == 1) PG8_BAR;
        PG8_WAIT_V(2); PG8_BAR;
        PG8_STAGE(PG8_SB(1, 0), cB + kstep, voffB); PG8_STAGE(PG8_SA(1, 0), cA + kstep, voffA); PG8_STAGE(PG8_SB(1, 1), cB + hstep + kstep, voffB);
        PG8_WAIT_V(6); PG8_BAR;
    } else {
        PG8_STAGE(PG8_SB(0, 0), cB, voffB); PG8_STAGE(PG8_SA(0, 0), cA, voffA); PG8_STAGE(PG8_SB(0, 1), cB + hstep, voffB); PG8_STAGE(PG8_SA(0, 1), cA + hstep, voffA);
        if (wr == 1) PG8_BAR;
        PG8_WAIT_V(4); PG8_BAR;
        PG8_STAGE(PG8_SB(1, 0), cB + kstep, voffB); PG8_STAGE(PG8_SA(1, 0), cA + kstep, voffA); PG8_STAGE(PG8_SB(1, 1), cB + hstep + kstep, voffB);
        PG8_WAIT_V(6); PG8_BAR;
    }
    for (;;) {
        const bool has_next = S.next(ui + 1, nxt);
        const char* nA = has_next ? (const char*)g.A + (size_t)nxt.pm * tstep : cA; const char* nB = has_next ? (const char*)g.Bt + (size_t)nxt.pn * tstep : cB;
        for (int t = 0; t < nt; t += 2) {
            const bool last = (t == nt - 2);
            const char* a1 = cA + (size_t)(t + 1) * kstep;
            const char* a2 = last ? nA : cA + (size_t)(t + 2) * kstep; const char* b2 = last ? nB : cB + (size_t)(t + 2) * kstep;
            const char* a3 = a2 + kstep; const char* b3 = b2 + kstep;
            if constexpr (SP2) {
            PG8_LDB(B0, 0, 0); PG8_LDB(B1, 0, 1); PG8_SCHED; PG8_LDA(At, 0, 0); PG8_STAGE(PG8_SA(1, 1), a1 + hstep, voffA);
            PG8_WAIT_V(8); PG8_WAIT_L(0); PG8_BAR; PG8_MMA(0, 0, At, B0); PG8_MMA(0, 1, At, B1); PG8_BAR; PG8_SCHED;
            PG8_LDA(At, 0, 1); PG8_STAGE(PG8_SB(0, 0), b2, voffB); PG8_STAGE(PG8_SB(0, 1), b2 + hstep, voffB); PG8_STAGE(PG8_SA(0, 0), a2, voffA);
            PG8_WAIT_V(8); PG8_WAIT_L(0); PG8_BAR; PG8_MMA(1, 0, At, B0); PG8_MMA(1, 1, At, B1); PG8_BAR; PG8_SCHED;
            PG8_LDB(B0, 1, 0); PG8_LDB(B1, 1, 1); PG8_SCHED; PG8_LDA(At, 1, 0); PG8_STAGE(PG8_SA(0, 1), a2 + hstep, voffA);
            PG8_WAIT_V(8); PG8_WAIT_L(0); PG8_BAR; PG8_MMA(0, 0, At, B0); PG8_MMA(0, 1, At, B1); PG8_BAR; PG8_SCHED;
            PG8_LDA(At, 1, 1); PG8_STAGE(PG8_SB(1, 0), b3, voffB); PG8_STAGE(PG8_SB(1, 1), b3 + hstep, voffB); PG8_STAGE(PG8_SA(1, 0), a3, voffA);
            PG8_WAIT_V(8); PG8_WAIT_L(0); PG8_BAR; PG8_MMA(1, 0, At, B0); PG8_MMA(1, 1, At, B1); PG8_BAR; PG8_SCHED;
            } else {
            PG8_LDB(B0, 0, 0); PG8_SCHED; PG8_LDA(At, 0, 0); PG8_STAGE(PG8_SA(1, 1), a1 + hstep, voffA);
            PG8_WAIT_L(8); PG8_BAR; PG8_WAIT_L(0); PG8_MMA(0, 0, At, B0); PG8_BAR; PG8_SCHED;
            PG8_LDB(B1, 0, 1); PG8_STAGE(PG8_SB(0, 0), b2, voffB);
            PG8_BAR; PG8_WAIT_L(0); PG8_MMA(0, 1, At, B1); PG8_BAR;
            PG8_LDA(At, 0, 1); PG8_STAGE(PG8_SA(0, 0), a2, voffA);
            PG8_BAR; PG8_WAIT_L(0); PG8_MMA(1, 0, At, B0); PG8_BAR; PG8_SCHED;
            PG8_STAGE(PG8_SB(0, 1), b2 + hstep, voffB);
            PG8_WAIT_V(6); PG8_BAR; PG8_MMA(1, 1, At, B1); PG8_BAR;
            PG8_LDB(B0, 1, 0); PG8_SCHED; PG8_LDA(At, 1, 0); PG8_STAGE(PG8_SA(0, 1), a2 + hstep, voffA);
            PG8_WAIT_L(8); PG8_BAR; PG8_WAIT_L(0); PG8_MMA(0, 0, At, B0); PG8_BAR; PG8_SCHED;
            PG8_LDB(B1, 1, 1); PG8_STAGE(PG8_SB(1, 0), b3, voffB);
            PG8_BAR; PG8_WAIT_L(0); PG8_MMA(0, 1, At, B1); PG8_BAR;
            PG8_LDA(At, 1, 1); PG8_STAGE(PG8_SA(1, 0), a3, voffA);
            PG8_BAR; PG8_WAIT_L(0); PG8_MMA(1, 0, At, B0); PG8_BAR; PG8_SCHED;
            PG8_STAGE(PG8_SB(1, 1), b3 + hstep, voffB);
            PG8_WAIT_V(6); PG8_BAR; PG8_MMA(1, 1, At, B1); PG8_BAR;
            }
        }
        if constexpr (ALIGN_EPI) { if (wr == 0) PG8_BAR; }
        if constexpr (!Epi::AFTER_DRAIN) { E(acc, cur, wr, wc, fr, fq); }
        if (!has_next) break;
#pragma unroll
        for (int a = 0; a < 2; ++a)
#pragma unroll
            for (int b = 0; b < 2; ++b)
#pragma unroll
                for (int m = 0; m < 4; ++m)
#pragma unroll
                    for (int n = 0; n < 2; ++n) acc[a][b][m][n] = (f32x4){0.f, 0.f, 0.f, 0.f};
        cur = nxt; cA = nA; cB = nB; ++ui;
        if constexpr (ALIGN_EPI) { if (wr == 1) PG8_BAR; }
    }
    PG8_WAIT_V(0);
    if constexpr (!ALIGN_EPI) { if (wr == 0) PG8_BAR; }
    PG8_BAR;
    if constexpr (Epi::AFTER_DRAIN) { E.fused(acc, cur, wr, wc, fr, fq, lds, wid, lane); }
#undef PG8_SA
#undef PG8_SB
#undef PG8_STAGE
#undef PG8_LDA
#undef PG8_LDB
#undef PG8_MMA
#undef PG8_WAIT_V
#undef PG8_WAIT_L
#undef PG8_BAR
#undef PG8_SCHED
}
}

namespace att {
constexpr int KB_OFF = 0, VB_OFF = 32768, TBL_OFF = 65536, OST_OFF = 68608, WS_OFF = OST_OFF + 8 * 4096, LDS_END = WS_OFF + 8 * 128;
__device__ __forceinline__ int crow(int r, int hi) { return (r & 3) + 8 * (r >> 2) + 4 * hi; }
#define ATT_WAIT_BAR() asm volatile("s_waitcnt vmcnt(0) lgkmcnt(0)\n\ts_barrier" ::: "memory")
__device__ __forceinline__ void glds16(const void* gsrc, unsigned lds_dst) { unsigned keep;
    asm volatile("s_mov_b32 %0, m0\n\ts_mov_b32 m0, %2\n\ts_nop 0\n\tglobal_load_lds_dwordx4 %1, off\n\ts_mov_b32 m0, %0" : "=&s"(keep) : "v"(gsrc), "s"(lds_dst) : "memory"); }

struct StreamDesc {
    const bf16_t* Q; const bf16_t* K; const bf16_t* V;
    int i0, R;
    const float* tblg;
    bf16_t* O; int o_row0, o_rstride;
    float* L;
};
constexpr int S_KB = 0, S_VB = 49152, S_TBL = 98304, S_OST = 101376, S_WS = S_OST + 8 * 4096, S_END = S_WS + 8 * 128;
__device__ __forceinline__ void stream(LAS unsigned char* lds, const StreamDesc& U) {
    const int tid = threadIdx.x, lane = tid & 63, r32 = lane & 31, hi = lane >> 5; const int wid = __builtin_amdgcn_readfirstlane(tid >> 6);
    LAS float* tbl = (LAS float*)(lds + S_TBL);
    { int t_ = tid; asm volatile("" : "+v"(t_));
      for (int i = t_; i < TBLA_N / 4; i += 512) ((LAS f32x4*)tbl)[i] = ((const f32x4*)U.tblg)[i]; }
    const unsigned lds0 = (unsigned)(uintptr_t)lds;
#define ATT_DMA(t) do { int l_ = lane; asm volatile("" : "+v"(l_)); const int sl_ = (t) % 6; \
        glds16(U.K + (size_t)l_ * 64 + wid * 8 + (size_t)(t) * 4096, (unsigned)__builtin_amdgcn_readfirstlane((int)(lds0 + S_KB + sl_ * 8192 + wid * 1024))); \
        glds16(U.V + (size_t)(16 * (wid & 3) + (l_ >> 2)) * 64 + (wid >> 2) * 32 + (l_ & 3) * 8 + (size_t)(t) * 4096, (unsigned)__builtin_amdgcn_readfirstlane((int)(lds0 + S_VB + sl_ * 8192 + wid * 1024))); } while (0)
    const int t_first = (U.i0 >> 1) - 2 > 0 ? (U.i0 >> 1) - 2 : 0, t_last = (U.i0 >> 1) + 4 * U.R - 1;
    int r = 0;
    int qt = U.i0 + wid;
    bf16x8 qr[4], qn[4];
#pragma unroll
    for (int d0 = 0; d0 < 4; ++d0) { qr[d0] = *(const bf16x8*)(U.Q + (size_t)(qt * 32 + r32) * 64 + d0 * 16 + hi * 8);
        qn[d0] = *(const bf16x8*)(U.Q + (size_t)((U.R > 1 ? qt + 8 : qt) * 32 + r32) * 64 + d0 * 16 + hi * 8); }
    ATT_DMA(t_first); ATT_DMA(t_first + 1);
    f32x16 o[2], ol; o[0] = (f32x16){0.f, 0.f, 0.f, 0.f, 0.f, 0.f, 0.f, 0.f, 0.f, 0.f, 0.f, 0.f, 0.f, 0.f, 0.f, 0.f}; o[1] = o[0]; ol = o[0];
    const int vb0 = (int)(unsigned)(uintptr_t)(lds + S_VB) + ((lane >> 4) & 1) * 32 + (lane & 3) * 8 + (4 * hi + ((lane & 15) >> 2)) * 64;
    const bf16x8 ones = {0x3F80, 0x3F80, 0x3F80, 0x3F80, 0x3F80, 0x3F80, 0x3F80, 0x3F80};
    LAS bf16_t* stg = (LAS bf16_t*)(lds + S_OST) + wid * 2048;
    LAS float* wsl = (LAS float*)(lds + S_WS) + wid * 32;
    ATT_WAIT_BAR();
#define ST_TILE(tt) do { const int kbase_ = (tt) * 64, qrow_ = qt * 32 + r32, sl_ = (tt) % 6; \
        const LAS float* tp_ = tbl + (383 - (qrow_ - kbase_) + 4 * hi); f32x16 p0, p1; \
        _Pragma("unroll") for (int rr = 0; rr < 16; ++rr) { const int cc = (rr & 3) + 8 * (rr >> 2); p0[rr] = tp_[cc]; p1[rr] = tp_[cc + 32]; } \
        const LAS unsigned char* kb_ = lds + S_KB + sl_ * 8192 + hi * 1024 + r32 * 16; \
        _Pragma("unroll") for (int d0 = 0; d0 < 4; ++d0) { const bf16x8 kf0_ = *(const LAS bf16x8*)(kb_ + d0 * 2048), kf1_ = *(const LAS bf16x8*)(kb_ + d0 * 2048 + 512); \
            p0 = __builtin_amdgcn_mfma_f32_32x32x16_bf16(kf0_, qr[d0], p0, 0, 0, 0); p1 = __builtin_amdgcn_mfma_f32_32x32x16_bf16(kf1_, qr[d0], p1, 0, 0, 0); } \
        _Pragma("unroll") for (int rr = 0; rr < 16; ++rr) { p0[rr] = __builtin_amdgcn_exp2f(p0[rr]); p1[rr] = __builtin_amdgcn_exp2f(p1[rr]); } \
        u32x4 pw[4]; \
        _Pragma("unroll") for (int k = 0; k < 2; ++k) { pw[k] = (u32x4){cvtpk(p0[8 * k], p0[8 * k + 1]), cvtpk(p0[8 * k + 2], p0[8 * k + 3]), cvtpk(p0[8 * k + 4], p0[8 * k + 5]), cvtpk(p0[8 * k + 6], p0[8 * k + 7])}; \
            pw[2 + k] = (u32x4){cvtpk(p1[8 * k], p1[8 * k + 1]), cvtpk(p1[8 * k + 2], p1[8 * k + 3]), cvtpk(p1[8 * k + 4], p1[8 * k + 5]), cvtpk(p1[8 * k + 6], p1[8 * k + 7])}; } \
        _Pragma("unroll") for (int ks = 0; ks < 4; ++ks) ol = __builtin_amdgcn_mfma_f32_32x32x16_bf16(__builtin_bit_cast(bf16x8, pw[ks]), ones, ol, 0, 0, 0); \
        const int vb_ = vb0 + sl_ * 8192; \
        _Pragma("unroll") for (int d0 = 0; d0 < 2; ++d0) { s16x4 vlo[4], vhi[4]; \
            _Pragma("unroll") for (int ks = 0; ks < 4; ++ks) { vlo[ks] = __builtin_bit_cast(s16x4, __builtin_amdgcn_ds_read_tr16_b64_v4i16((LAS s16x4*)(uintptr_t)(unsigned)(vb_ + d0 * 4096 + ks * 1024))); \
                                                             vhi[ks] = __builtin_bit_cast(s16x4, __builtin_amdgcn_ds_read_tr16_b64_v4i16((LAS s16x4*)(uintptr_t)(unsigned)(vb_ + d0 * 4096 + ks * 1024 + 512))); } \
            _Pragma("unroll") for (int ks = 0; ks < 4; ++ks) { const bf16x8 vf = (bf16x8){vlo[ks][0], vlo[ks][1], vlo[ks][2], vlo[ks][3], vhi[ks][0], vhi[ks][1], vhi[ks][2], vhi[ks][3]}; \
                o[d0] = __builtin_amdgcn_mfma_f32_32x32x16_bf16(__builtin_bit_cast(bf16x8, pw[ks]), vf, o[d0], 0, 0, 0); } } } while (0)
    int pend_qt = -1;
#define ST_FLUSH() do { if (pend_qt >= 0) { \
        { const float lv = wsl[r32]; float* lp = U.L + (size_t)(U.o_row0 + (pend_qt * 32 + r32) * U.o_rstride) * 8; if (hi == 0) *lp = lv; } \
        _Pragma("unroll") for (int i = 0; i < 4; ++i) { const int row = i * 8 + (lane >> 3), ch = lane & 7; const u32x4 v = *(const LAS u32x4*)(stg + row * 64 + ch * 8); \
            *(u32x4*)(U.O + (size_t)(U.o_row0 + (pend_qt * 32 + row) * U.o_rstride) * 512 + ch * 8) = v; } \
        if (r + 1 < U.R) { _Pragma("unroll") for (int d0 = 0; d0 < 4; ++d0) qn[d0] = *(const bf16x8*)(U.Q + (size_t)((qt + 8) * 32 + r32) * 64 + d0 * 16 + hi * 8); } \
        pend_qt = -1; } } while (0)
    for (int t = t_first; t < t_last; t += 2) {
        if (t + 2 < t_last) { ATT_DMA(t + 2); ATT_DMA(t + 3); }
        ST_FLUSH();
        if (r < U.R) {
            const int wend = qt >> 1;
            const bool a0 = (t >= wend - 2) && (t <= wend), a1 = (t + 1 >= wend - 2) && (t + 1 <= wend);
            if (a0 && a1) { ST_TILE(t); ST_TILE(t + 1); }
            else if (a0) { ST_TILE(t); }
            else if (a1) { ST_TILE(t + 1); }
            if (wend == t || wend == t + 1) {
#pragma unroll
                for (int rr = 0; rr < 16; ++rr) { const int orow = crow(rr, hi);
#pragma unroll
                    for (int d0 = 0; d0 < 2; ++d0) stg[orow * 64 + d0 * 32 + r32] = (bf16_t)(cvtpk(o[d0][rr], 0.f) & 0xffffu);
                    if (r32 == 0) wsl[orow] = ol[rr]; }
                pend_qt = qt; ++r; qt += 8;
                o[0] = (f32x16){0.f, 0.f, 0.f, 0.f, 0.f, 0.f, 0.f, 0.f, 0.f, 0.f, 0.f, 0.f, 0.f, 0.f, 0.f, 0.f}; o[1] = o[0]; ol = o[0];
#pragma unroll
                for (int d0 = 0; d0 < 4; ++d0) qr[d0] = qn[d0];
            }
        }
        ATT_WAIT_BAR();
    }
    ST_FLUSH();
    asm volatile("s_waitcnt vmcnt(0)" ::: "memory");
#undef ST_FLUSH
#undef ATT_DMA
#undef ST_TILE
}

constexpr int D_KB = 0, D_VB = 32768, D_TBL = 65536, D_KM = 82944, D_OST = 91136, D_END = D_OST + 8 * 4096;
__device__ __forceinline__ void moba_pair(LAS unsigned char* lds, int p, const bf16_t* Qs, const bf16_t* Ks, const bf16_t* Vs, const float* tblg, const float* kmp0, const float* kmp1, bf16_t* O) {
    const int tid = threadIdx.x, lane = tid & 63, r32 = lane & 31, hi = lane >> 5; const int wid = __builtin_amdgcn_readfirstlane(tid >> 6);
    LAS float* tbl = (LAS float*)(lds + D_TBL);
    const int qbA = 2 * p, qbB = 2 * p + 1, NT = 8 * p + 8, NTA = 8 * p + 4;
    const unsigned lds0 = (unsigned)(uintptr_t)lds;
#define MD_DMA(t) do { int l_ = lane; asm volatile("" : "+v"(l_)); \
        glds16(Ks + (size_t)l_ * 64 + wid * 8 + (size_t)(t) * 4096, (unsigned)__builtin_amdgcn_readfirstlane((int)(lds0 + D_KB + ((t) & 3) * 8192 + wid * 1024))); \
        glds16(Vs + (size_t)(16 * (wid & 3) + (l_ >> 2)) * 64 + (wid >> 2) * 32 + (l_ & 3) * 8 + (size_t)(t) * 4096, (unsigned)__builtin_amdgcn_readfirstlane((int)(lds0 + D_VB + ((t) & 3) * 8192 + wid * 1024))); } while (0)
    for (int i = tid; i < TBLB_N / 4; i += 512) ((LAS f32x4*)tbl)[i] = ((const f32x4*)tblg)[i];
    {   LAS bf16_t* kmh = (LAS bf16_t*)(lds + D_KM); LAS bf16_t* kml = kmh + 32 * 64;
        for (int i = tid; i < 32 * 64; i += 512) { const int j = i >> 6, d = i & 63; float x = 0.f;
            if (j < qbB) x = (kmp0[(size_t)j * 1024 + d] + kmp1[(size_t)j * 1024 + d]) * (1.f / 256.f);
            const unsigned hb = cvtpk(x, 0.f) & 0xffffu; const float xl = x - bf2f((unsigned short)hb);
            kmh[i] = (bf16_t)hb; kml[i] = (bf16_t)(cvtpk(xl, 0.f) & 0xffffu); } }
    const int qrowA = qbA * 256 + wid * 32 + r32, qrowB = qrowA + 256;
    bf16x8 qrA[4], qrB[4];
#pragma unroll
    for (int d0 = 0; d0 < 4; ++d0) { qrA[d0] = *(const bf16x8*)(Qs + (size_t)qrowA * 64 + d0 * 16 + hi * 8); qrB[d0] = *(const bf16x8*)(Qs + (size_t)qrowB * 64 + d0 * 16 + hi * 8); }
    MD_DMA(0); MD_DMA(1);
    ATT_WAIT_BAR();
    MD_DMA(2);
    unsigned selA = 0u, selB = 0u;
#define MD_GATE(SEL, QR, QB) do { f32x16 g0 = {0.f, 0.f, 0.f, 0.f, 0.f, 0.f, 0.f, 0.f, 0.f, 0.f, 0.f, 0.f, 0.f, 0.f, 0.f, 0.f}; \
        const LAS unsigned char* kb_ = lds + D_KM + r32 * 128 + hi * 16; \
        _Pragma("unroll") for (int d0 = 0; d0 < 4; ++d0) { const bf16x8 ah = *(const LAS bf16x8*)(kb_ + d0 * 32), al = *(const LAS bf16x8*)(kb_ + 4096 + d0 * 32); \
            g0 = __builtin_amdgcn_mfma_f32_32x32x16_bf16(ah, QR[d0], g0, 0, 0, 0); g0 = __builtin_amdgcn_mfma_f32_32x32x16_bf16(al, QR[d0], g0, 0, 0, 0); } \
        float gt[16]; \
        _Pragma("unroll") for (int r = 0; r < 8; ++r) { const float mine = g0[r], oth = __shfl_xor(mine, 32); const int jm = (r & 3) + 8 * (r >> 2); gt[jm] = hi ? oth : mine; gt[jm + 4] = hi ? mine : oth; } \
        _Pragma("unroll") for (int rep = 0; rep < 3; ++rep) { float best = -__builtin_inff(); int bi = -1; \
            _Pragma("unroll") for (int j = 0; j < 16; ++j) { const bool ok = (j < (QB)) && !((SEL >> j) & 1u) && (gt[j] > best); if (ok) { best = gt[j]; bi = j; } } \
            if (bi >= 0) SEL |= 1u << bi; } \
        SEL |= 1u << (QB); } while (0)
    MD_GATE(selA, qrA, qbA);
    MD_GATE(selB, qrB, qbB);
    LAS unsigned char* qal = lds + D_OST + wid * 4096 + lane * 16;
#pragma unroll
    for (int d0 = 0; d0 < 4; ++d0) *(LAS bf16x8*)(qal + d0 * 1024) = qrA[d0];
#define QA(d0) (*(const LAS bf16x8*)(qal + (d0) * 1024))
#define QB_(d0) qrB[d0]
    const int vb0 = (int)(unsigned)(uintptr_t)(lds + D_VB) + ((lane >> 4) & 1) * 32 + (lane & 3) * 8 + (4 * hi + ((lane & 15) >> 2)) * 64;
    f32x16 oA[2], oB[2]; float olA = 0.f, olB = 0.f; oA[0] = (f32x16){0.f, 0.f, 0.f, 0.f, 0.f, 0.f, 0.f, 0.f, 0.f, 0.f, 0.f, 0.f, 0.f, 0.f, 0.f, 0.f}; oA[1] = oA[0]; oB[0] = oA[0]; oB[1] = oA[0];
#define MD_QK(P0, P1, SEL, QROW, QR, t) do { const int kb_ = 64 * (t); const bool sel_ = (SEL >> ((t) >> 2)) & 1u; \
        const int base_ = sel_ ? (4095 - (QROW - kb_) + 4 * hi) : (4096 + 4 * hi); const LAS float* tp_ = tbl + base_; \
        _Pragma("unroll") for (int r = 0; r < 16; ++r) { const int cc = (r & 3) + 8 * (r >> 2); P0[r] = tp_[cc]; P1[r] = tp_[cc + 32]; } \
        const LAS unsigned char* kq_ = lds + D_KB + ((t) & 3) * 8192 + hi * 1024 + r32 * 16; \
        _Pragma("unroll") for (int d0 = 0; d0 < 4; ++d0) { const bf16x8 kf0_ = *(const LAS bf16x8*)(kq_ + d0 * 2048), kf1_ = *(const LAS bf16x8*)(kq_ + d0 * 2048 + 512); \
            const bf16x8 qf_ = QR(d0); P0 = __builtin_amdgcn_mfma_f32_32x32x16_bf16(kf0_, qf_, P0, 0, 0, 0); P1 = __builtin_amdgcn_mfma_f32_32x32x16_bf16(kf1_, qf_, P1, 0, 0, 0); } } while (0)
#define MD_EXP(PW, P0, P1, OL) do { float s_ = 0.f; \
        _Pragma("unroll") for (int r = 0; r < 16; ++r) { P0[r] = __builtin_amdgcn_exp2f(P0[r]); P1[r] = __builtin_amdgcn_exp2f(P1[r]); s_ += P0[r] + P1[r]; } OL += s_; \
        _Pragma("unroll") for (int k = 0; k < 2; ++k) { PW[k] = (u32x4){cvtpk(P0[8 * k], P0[8 * k + 1]), cvtpk(P0[8 * k + 2], P0[8 * k + 3]), cvtpk(P0[8 * k + 4], P0[8 * k + 5]), cvtpk(P0[8 * k + 6], P0[8 * k + 7])}; \
            PW[2 + k] = (u32x4){cvtpk(P1[8 * k], P1[8 * k + 1]), cvtpk(P1[8 * k + 2], P1[8 * k + 3]), cvtpk(P1[8 * k + 4], P1[8 * k + 5]), cvtpk(P1[8 * k + 6], P1[8 * k + 7])}; } } while (0)
#define MD_PV(OO, PW, t) do { const int vb_ = vb0 + ((t) & 3) * 8192; \
        _Pragma("unroll") for (int d0 = 0; d0 < 2; ++d0) { s16x4 vlo[4], vhi[4]; \
            _Pragma("unroll") for (int ks = 0; ks < 4; ++ks) { vlo[ks] = __builtin_bit_cast(s16x4, __builtin_amdgcn_ds_read_tr16_b64_v4i16((LAS s16x4*)(uintptr_t)(unsigned)(vb_ + d0 * 4096 + ks * 1024))); \
                                                             vhi[ks] = __builtin_bit_cast(s16x4, __builtin_amdgcn_ds_read_tr16_b64_v4i16((LAS s16x4*)(uintptr_t)(unsigned)(vb_ + d0 * 4096 + ks * 1024 + 512))); } \
            _Pragma("unroll") for (int ks = 0; ks < 4; ++ks) { const bf16x8 vf = (bf16x8){vlo[ks][0], vlo[ks][1], vlo[ks][2], vlo[ks][3], vhi[ks][0], vhi[ks][1], vhi[ks][2], vhi[ks][3]}; \
                OO[d0] = __builtin_amdgcn_mfma_f32_32x32x16_bf16(__builtin_bit_cast(bf16x8, PW[ks]), vf, OO[d0], 0, 0, 0); } } } while (0)
#define MD_SB() __builtin_amdgcn_sched_barrier(0)
    for (int t = 0; t < NT; ++t) {
        const bool dma = (t + 3 < NT);
        if (dma) MD_DMA(t + 3);
        if (t < NTA) {
            f32x16 a0, a1, b0, b1; u32x4 pwa[4], pwb[4];
            { const int kb_ = 64 * t; const bool sa_ = (selA >> (t >> 2)) & 1u, sb_ = (selB >> (t >> 2)) & 1u;
              const LAS float* ta_ = tbl + (sa_ ? (4095 - (qrowA - kb_) + 4 * hi) : (4096 + 4 * hi)); const LAS float* tb_ = tbl + (sb_ ? (4095 - (qrowB - kb_) + 4 * hi) : (4096 + 4 * hi));
#pragma unroll
              for (int r = 0; r < 16; ++r) { const int cc = (r & 3) + 8 * (r >> 2); a0[r] = ta_[cc]; a1[r] = ta_[cc + 32]; b0[r] = tb_[cc]; b1[r] = tb_[cc + 32]; }
              const LAS unsigned char* kq_ = lds + D_KB + (t & 3) * 8192 + hi * 1024 + r32 * 16;
#pragma unroll
              for (int d0 = 0; d0 < 4; ++d0) { const bf16x8 kf0_ = *(const LAS bf16x8*)(kq_ + d0 * 2048), kf1_ = *(const LAS bf16x8*)(kq_ + d0 * 2048 + 512); const bf16x8 qa_ = QA(d0), qb_ = qrB[d0];
                  a0 = __builtin_amdgcn_mfma_f32_32x32x16_bf16(kf0_, qa_, a0, 0, 0, 0); a1 = __builtin_amdgcn_mfma_f32_32x32x16_bf16(kf1_, qa_, a1, 0, 0, 0);
                  b0 = __builtin_amdgcn_mfma_f32_32x32x16_bf16(kf0_, qb_, b0, 0, 0, 0); b1 = __builtin_amdgcn_mfma_f32_32x32x16_bf16(kf1_, qb_, b1, 0, 0, 0); } }
            MD_EXP(pwa, a0, a1, olA); MD_EXP(pwb, b0, b1, olB);
            { const int vb_ = vb0 + (t & 3) * 8192;
#pragma unroll
              for (int d0 = 0; d0 < 2; ++d0) { s16x4 vlo[4], vhi[4];
#pragma unroll
                  for (int ks = 0; ks < 4; ++ks) { vlo[ks] = __builtin_bit_cast(s16x4, __builtin_amdgcn_ds_read_tr16_b64_v4i16((LAS s16x4*)(uintptr_t)(unsigned)(vb_ + d0 * 4096 + ks * 1024)));
                                                   vhi[ks] = __builtin_bit_cast(s16x4, __builtin_amdgcn_ds_read_tr16_b64_v4i16((LAS s16x4*)(uintptr_t)(unsigned)(vb_ + d0 * 4096 + ks * 1024 + 512))); }
#pragma unroll
                  for (int ks = 0; ks < 4; ++ks) { const bf16x8 vf = (bf16x8){vlo[ks][0], vlo[ks][1], vlo[ks][2], vlo[ks][3], vhi[ks][0], vhi[ks][1], vhi[ks][2], vhi[ks][3]};
                      oA[d0] = __builtin_amdgcn_mfma_f32_32x32x16_bf16(__builtin_bit_cast(bf16x8, pwa[ks]), vf, oA[d0], 0, 0, 0);
                      oB[d0] = __builtin_amdgcn_mfma_f32_32x32x16_bf16(__builtin_bit_cast(bf16x8, pwb[ks]), vf, oB[d0], 0, 0, 0); } } }
        } else {
            f32x16 b0, b1; u32x4 pwb[4];
            MD_QK(b0, b1, selB, qrowB, QB_, t); MD_EXP(pwb, b0, b1, olB); MD_PV(oB, pwb, t);
        }
        if (t + 3 < NT) asm volatile("s_waitcnt vmcnt(4) lgkmcnt(0)\n\ts_barrier" ::: "memory");
        else if (t + 2 < NT) asm volatile("s_waitcnt vmcnt(2) lgkmcnt(0)\n\ts_barrier" ::: "memory");
        else ATT_WAIT_BAR();
    }
    LAS bf16_t* stg = (LAS bf16_t*)(lds + D_OST) + wid * 2048;
    LAS float* wsf = (LAS float*)(lds + D_KM) + wid * 64;
#define MD_OUT(OO, OL, QB) do { { float l_ = OL + __shfl_xor(OL, 32); if (hi == 0) wsf[r32] = __builtin_amdgcn_rcpf(l_); } asm volatile("s_waitcnt lgkmcnt(0)" ::: "memory"); \
        _Pragma("unroll") for (int r = 0; r < 16; ++r) { const int orow = crow(r, hi); const float sc = wsf[orow]; \
            _Pragma("unroll") for (int d0 = 0; d0 < 2; ++d0) stg[orow * 64 + d0 * 32 + r32] = (bf16_t)(cvtpk(OO[d0][r] * sc, 0.f) & 0xffffu); } \
        asm volatile("s_waitcnt lgkmcnt(0)" ::: "memory"); \
        _Pragma("unroll") for (int i = 0; i < 4; ++i) { const int row = i * 8 + (lane >> 3), ch = lane & 7; const u32x4 v = *(const LAS u32x4*)(stg + row * 64 + ch * 8); \
            *(u32x4*)(O + (size_t)((QB) * 256 + wid * 32 + row) * 1024 + ch * 8) = v; } \
        asm volatile("s_waitcnt lgkmcnt(0)" ::: "memory"); } while (0)
    MD_OUT(oA, olA, qbA);
    MD_OUT(oB, olB, qbB);
    ATT_WAIT_BAR();
#undef MD_DMA
#undef MD_GATE
#undef MD_QK
#undef MD_EXP
#undef MD_PV
#undef MD_SB
#undef QA
#undef QB_
#undef MD_OUT
}
}

constexpr int NWAVES = 8;
#ifndef MK_N_LAUNCHES
#define MK_N_LAUNCHES 1
#endif
constexpr int N_LAUNCHES = MK_N_LAUNCHES, PER_PHASE = 12;
constexpr size_t MiB = 1u << 20;
constexpr size_t WS_CTL = 0, CTL_ZERO_BYTES = 32 * 1024;
constexpr size_t WS_SS = 1 * MiB;
constexpr size_t WS_KM = WS_SS + 512 * 1024;
constexpr size_t WS_TBLB = 2 * MiB;
constexpr size_t WS_TBLA = WS_TBLB + 512 * 1024;
constexpr size_t WS_LA = 3 * MiB;
constexpr size_t WS_W = 6 * MiB;
constexpr size_t W_QKV0 = WS_W, W_O0 = W_QKV0 + 9 * MiB, W_QKV1 = W_O0 + 1 * MiB, W_O1 = W_QKV1 + 6 * MiB, W_UP0 = W_O1 + 2 * MiB, W_UP1 = W_UP0 + 8 * MiB, W_DN0 = W_UP1 + 8 * MiB, W_DN1 = W_DN0 + 8 * MiB;
constexpr size_t WS_HB = 56 * MiB;
constexpr size_t WS_OG = 56 * MiB;
constexpr size_t WS_QKV = 104 * MiB;
constexpr size_t WS_O0 = 104 * MiB;
constexpr size_t WS_O1 = 200 * MiB;
constexpr size_t WS_H = 104 * MiB;
constexpr size_t WS_END = 256 * MiB;
static_assert(W_DN1 + 8 * MiB == WS_HB && WS_H + 128 * MiB <= WS_END && WS_QKV + 144 * MiB <= WS_END, "d_ws map");
constexpr int CW_BAR = 4096;
constexpr int RING_BYTES = 131072, LDS_BYTES = 163840, LDSCTL_OFF = LDS_BYTES - 512, MISC_OFF = LDSCTL_OFF + 320;
static_assert(att::S_END <= LDSCTL_OFF && att::D_END <= RING_BYTES, "attention LDS");

typedef GAS unsigned gu32;
#define RLX_AGENT __ATOMIC_RELAXED, __HIP_MEMORY_SCOPE_AGENT
#define XB_TMO      128
#define XB_XCNT(j)  (256  + 64 * (j))
#define XB_XSUB(j)  (1280 + 64 * (j))
#define XB_XGEN(j)  (2304 + 64 * (j))
#define XB_TOP      3328
#define XB_TOPGEN   3392
#define XCD_BAR_WORDS 3456
#define XB_SPIN_CAP (1u << 18)
__device__ __forceinline__ unsigned xb_ld(unsigned* p)              { return __hip_atomic_load(p, __ATOMIC_RELAXED, __HIP_MEMORY_SCOPE_AGENT); }
__device__ __forceinline__ unsigned xb_add(unsigned* p, unsigned v) { return __hip_atomic_fetch_add(p, v, __ATOMIC_RELAXED, __HIP_MEMORY_SCOPE_AGENT); }
__device__ __forceinline__ unsigned xb_xcc_id() { return (unsigned)__builtin_amdgcn_s_getreg((3 << 11) | 20) & 0xFu; }
#define XB_SPIN(cond, bar) do { unsigned _sp = 0; while (cond) { __builtin_amdgcn_s_sleep(1); \
    if ((++_sp & 255u) == 0u) { if (xb_ld(&(bar)[XB_TMO])) break; if (_sp > XB_SPIN_CAP) { atomicAdd(&(bar)[XB_TMO], 1u); break; } } } } while (0)
struct XcdBarrier { unsigned* bar; unsigned x; volatile LAS unsigned* st; };
__device__ __forceinline__ XcdBarrier xcd_barrier_post(unsigned* bar, volatile LAS unsigned* st) {
    XcdBarrier b; b.bar = bar; b.x = xb_xcc_id(); b.st = st;
    if (threadIdx.x == 0) (void)xb_add(&bar[XB_XCNT(b.x)], 1u);
    return b;
}
__device__ __forceinline__ void xcd_barrier_complete(unsigned* bar, unsigned x, unsigned& nloc, unsigned& nx) {
    const unsigned G = gridDim.x * gridDim.y * gridDim.z;
    unsigned sum, cnt, mine, sp = 0u;
    for (;;) {
        sum = 0u; cnt = 0u; mine = 0u;
#pragma unroll
        for (unsigned j = 0; j < 16; ++j) { const unsigned c = xb_ld(&bar[XB_XCNT(j)]); sum += c; cnt += (c > 0u) ? 1u : 0u; mine = (j == x) ? c : mine; }
        if (sum == G) break;
        __builtin_amdgcn_s_sleep(1);
        if ((++sp & 255u) == 0u) { if (xb_ld(&bar[XB_TMO])) break; if (sp > XB_SPIN_CAP) { atomicAdd(&bar[XB_TMO], 1u); break; } }
    }
    nloc = mine > 0u ? mine : 1u; nx = cnt > 0u ? cnt : 1u;
}
__device__ __forceinline__ void xcd_barrier(const XcdBarrier& b) {
    asm volatile("s_waitcnt vmcnt(0)" ::: "memory");
    __syncthreads();
    if (threadIdx.x == 0) {
        unsigned* bar = b.bar;
        __builtin_amdgcn_s_waitcnt(0);
        unsigned nloc = b.st[0], nx = b.st[1];
        if (nloc == 0u) { xcd_barrier_complete(bar, b.x, nloc, nx); b.st[0] = nloc; b.st[1] = nx; }
        const unsigned old = xb_add(&bar[XB_XSUB(b.x)], 1u);
        const unsigned gen = old / nloc;
        if (old + 1u == (gen + 1u) * nloc) {
            __builtin_amdgcn_fence(__ATOMIC_RELEASE, "agent");
            asm volatile("s_waitcnt vmcnt(0)" ::: "memory");
            const unsigned og = xb_add(&bar[XB_TOP], 1u);
            const unsigned tg = og / nx;
            if (og + 1u == (tg + 1u) * nx) xb_add(&bar[XB_TOPGEN], 1u);
            else XB_SPIN(xb_ld(&bar[XB_TOPGEN]) == tg, bar);
            __builtin_amdgcn_fence(__ATOMIC_ACQUIRE, "agent");
            xb_add(&bar[XB_XGEN(b.x)], 1u);
            asm volatile("s_waitcnt vmcnt(0)" ::: "memory");
        } else {
            XB_SPIN(xb_ld(&bar[XB_XGEN(b.x)]) == gen, bar);
            __builtin_amdgcn_fence(__ATOMIC_ACQUIRE, "agent");
            asm volatile("s_waitcnt vmcnt(0)" ::: "memory");
        }
    }
    __syncthreads();
}

__device__ __forceinline__ float wave_sum(float v) {
#pragma unroll
    for (int o = 1; o < 64; o <<= 1) v += __shfl_xor(v, o);
    return v;
}
__device__ __forceinline__ float wave_max(float v) {
#pragma unroll
    for (int o = 1; o < 64; o <<= 1) v = fmaxf(v, __shfl_xor(v, o));
    return v;
}
__device__ __forceinline__ void p0_transpose_item(const float* W, int K, int N, bf16_t* WT, const float* gain, bool perm, LAS float* scr, int item, int lane) {
    const int nblk = N / 32, kb = item / nblk, nb = item % nblk, k0 = 64 * kb, n0 = 32 * nb;
    const int kr = lane >> 3, c4 = (lane & 7) * 4;
    f32x4 v[8]; float gs[8];
#pragma unroll
    for (int i = 0; i < 8; ++i) { v[i] = *(const f32x4*)(W + (size_t)(k0 + 8 * i + kr) * N + n0 + c4); gs[i] = gain ? gain[k0 + 8 * i + kr] : 1.f; }
#pragma unroll
    for (int i = 0; i < 8; ++i) { LAS float* s = scr + (8 * i + kr) * 33 + c4; s[0] = v[i][0] * gs[i]; s[1] = v[i][1] * gs[i]; s[2] = v[i][2] * gs[i]; s[3] = v[i][3] * gs[i]; }
    asm volatile("s_waitcnt lgkmcnt(0)" ::: "memory");
    const int c = lane & 7;
    const int orow0 = perm ? ((n0 & ~255) + ((n0 >> 5) & 1) * 128 + ((n0 >> 6) & 3) * 32) : n0;
#pragma unroll
    for (int j = 0; j < 4; ++j) { const int n = (lane >> 3) + 8 * j; const LAS float* s = scr + (8 * c) * 33 + n;
        u32x4 o; o.x = cvtpk(s[0 * 33], s[1 * 33]); o.y = cvtpk(s[2 * 33], s[3 * 33]); o.z = cvtpk(s[4 * 33], s[5 * 33]); o.w = cvtpk(s[6 * 33], s[7 * 33]);
        *(u32x4*)(WT + (size_t)(orow0 + n) * K + k0 + 8 * c) = o; }
    asm volatile("s_waitcnt lgkmcnt(0)" ::: "memory");
}
__device__ __forceinline__ int t5_bucket(int n) {
    if (n < 16) return n;
    const int thr[15] = {22, 30, 40, 54, 73, 99, 134, 182, 246, 332, 450, 609, 825, 1117, 1513};
    int b = 16;
#pragma unroll
    for (int k = 0; k < 15; ++k) b += (n >= thr[k]) ? 1 : 0;
    return b;
}

struct Args { const float* in[14]; float* out; unsigned char* ws; int ph_lo, ph_hi, li, pad; };

__global__ void __launch_bounds__(NWAVES * 64, 2) hybrid_fwd(Args args) {
    extern __shared__ __attribute__((aligned(16))) unsigned char lds_raw[];
    LAS unsigned char* lds = (LAS unsigned char*)lds_raw;
    volatile LAS unsigned* MISC = (volatile LAS unsigned*)(lds + MISC_OFF);
    const int tid = threadIdx.x, lane = tid & 63, wave = __builtin_amdgcn_readfirstlane(tid >> 6);
    const int G = gridDim.x, bx = blockIdx.x, vcu = (G % 8 == 0) ? (bx % 8) * (G / 8) + bx / 8 : bx;
    unsigned char* ws = args.ws;
    unsigned* ctl = (unsigned*)(ws + WS_CTL);
    const float* x = args.in[0]; const float* rel_bias = args.in[1]; const float* norm_mix = args.in[2]; const float* norm_ffn = args.in[3];
    const float* a_w_qkv = args.in[4]; const float* a_q_gain = args.in[5]; const float* a_k_gain = args.in[6]; const float* a_w_o = args.in[7];
    const float* b_w_qkv = args.in[8]; const float* b_q_gain = args.in[9]; const float* b_k_gain = args.in[10]; const float* b_w_o = args.in[11];
    const float* ffn_w1 = args.in[12]; const float* ffn_w2 = args.in[13];
    float* out = args.out;
    float* ssp = (float*)(ws + WS_SS); float* kmp = (float*)(ws + WS_KM); float* tblB = (float*)(ws + WS_TBLB); float* tblA = (float*)(ws + WS_TBLA); float* la = (float*)(ws + WS_LA);
    bf16_t* HB = (bf16_t*)(ws + WS_HB); bf16_t* OG = (bf16_t*)(ws + WS_OG); bf16_t* QKV = (bf16_t*)(ws + WS_QKV); bf16_t* O0 = (bf16_t*)(ws + WS_O0); bf16_t* O1 = (bf16_t*)(ws + WS_O1); bf16_t* HH = (bf16_t*)(ws + WS_H);

    for (int u = tid; u < (LDS_BYTES - LDSCTL_OFF) / 4; u += NWAVES * 64) ((LAS unsigned*)(lds + LDSCTL_OFF))[u] = 0u;
    __syncthreads();
    XcdBarrier bar; bar.bar = ctl + CW_BAR; bar.x = 0; bar.st = nullptr;
    if (N_LAUNCHES != PER_PHASE) bar = xcd_barrier_post(ctl + CW_BAR, MISC + 8);
#define GRID_BAR() do { if (N_LAUNCHES != PER_PHASE) xcd_barrier(bar); } while (0)
    const int lo = args.ph_lo, hi = args.ph_hi;
#define IN(k) (lo <= (k) && (k) < hi)
#define BOTH(k) (IN(k) && IN((k) + 1))

    constexpr int I0 = (DM / 64) * (NQKV0 / 32), I1 = (NO0 / 64) * (DM / 32), I2 = (DM / 64) * (NQKV1 / 32), I3 = (NO1 / 64) * (DM / 32), I4 = (DM / 64) * (FF / 32), I5 = (FF / 64) * (DM / 32);
    constexpr int NITEMS_A = I0 + I1, NITEMS = NITEMS_A + I4 + I5 + I2 + I3 + I4 + I5;
#define P0_ITEM(it_) do { int r = (it_); LAS float* scr_ = (LAS float*)(lds + wave * 16384); \
        if (r < I0) { p0_transpose_item(a_w_qkv, DM, NQKV0, (bf16_t*)(ws + W_QKV0), norm_mix, true, scr_, r, lane); break; } r -= I0; \
        if (r < I1) { p0_transpose_item(a_w_o, NO0, DM, (bf16_t*)(ws + W_O0), nullptr, false, scr_, r, lane); break; } r -= I1; \
        if (r < I4) { p0_transpose_item(ffn_w1, DM, FF, (bf16_t*)(ws + W_UP0), norm_ffn, false, scr_, r, lane); break; } r -= I4; \
        if (r < I5) { p0_transpose_item(ffn_w2, FF, DM, (bf16_t*)(ws + W_DN0), nullptr, false, scr_, r, lane); break; } r -= I5; \
        if (r < I2) { p0_transpose_item(b_w_qkv, DM, NQKV1, (bf16_t*)(ws + W_QKV1), norm_mix + DM, true, scr_, r, lane); break; } r -= I2; \
        if (r < I3) { p0_transpose_item(b_w_o, NO1, DM, (bf16_t*)(ws + W_O1), nullptr, false, scr_, r, lane); break; } r -= I3; \
        if (r < I4) { p0_transpose_item(ffn_w1 + (size_t)DM * FF, DM, FF, (bf16_t*)(ws + W_UP1), norm_ffn + DM, false, scr_, r, lane); break; } r -= I4; \
        p0_transpose_item(ffn_w2 + (size_t)FF * DM, FF, DM, (bf16_t*)(ws + W_DN1), nullptr, false, scr_, r, lane); } while (0)
    if (IN(0)) {
        const int gw = vcu * NWAVES + wave, NGW = G * NWAVES;
        for (int it = gw; it < NITEMS_A; it += NGW) P0_ITEM(it);
        for (int m = 2 * gw; m < MTOK; m += 2 * NGW) {
            f32x4 v[2][4]; float s[2] = {0.f, 0.f};
#pragma unroll
            for (int q = 0; q < 2; ++q)
#pragma unroll
                for (int j = 0; j < 2; ++j) { const f32x4* xp = (const f32x4*)(x + (size_t)(m + q) * DM + 512 * j + 8 * lane); v[q][2 * j] = xp[0]; v[q][2 * j + 1] = xp[1]; }
#pragma unroll
            for (int q = 0; q < 2; ++q) {
#pragma unroll
                for (int j = 0; j < 4; ++j) s[q] += (v[q][j][0] * v[q][j][0] + v[q][j][1] * v[q][j][1]) + (v[q][j][2] * v[q][j][2] + v[q][j][3] * v[q][j][3]);
                s[q] = wave_sum(s[q]);
#pragma unroll
                for (int j = 0; j < 2; ++j) { u32x4 w; w.x = cvtpk(v[q][2 * j][0], v[q][2 * j][1]); w.y = cvtpk(v[q][2 * j][2], v[q][2 * j][3]); w.z = cvtpk(v[q][2 * j + 1][0], v[q][2 * j + 1][1]); w.w = cvtpk(v[q][2 * j + 1][2], v[q][2 * j + 1][3]);
                    *(u32x4*)(HB + (size_t)(m + q) * DM + 512 * j + 8 * lane) = w; }
                if (lane == 0) *(f32x4*)(ssp + (size_t)(m + q) * 4) = (f32x4){s[q], 0.f, 0.f, 0.f};
            }
        }
        {
            float mb = 0.f;
            for (int i = lane; i < 32 * 24; i += 64) mb = fmaxf(mb, rel_bias[i]);
            mb = wave_max(mb);
            const float refA = (8.f * wave_max(fabsf(a_q_gain[lane])) * wave_max(fabsf(a_k_gain[lane])) + mb) * LOG2E;
            const float refB = (8.f * wave_max(fabsf(b_q_gain[lane])) * wave_max(fabsf(b_k_gain[lane])) + mb) * LOG2E;
            const int gt = vcu * 512 + tid, NGT = G * 512;
            for (int e = gt; e < 16 * TBLB_N; e += NGT) { const int h = e / TBLB_N, idx = e % TBLB_N, dist = 4095 - idx;
                tblB[e] = (dist < 0) ? NEGV : rel_bias[t5_bucket(dist) * 24 + h] * LOG2E - refB; }
            for (int e = gt; e < 24 * TBLA_N; e += NGT) { const int col = e / TBLA_N, idx = e % TBLA_N, dist = 383 - idx, g = col >> 3;
                tblA[e] = (dist < 0 || dist > 128) ? NEGV : rel_bias[t5_bucket(dist << (2 * g)) * 24 + col] * LOG2E - refA; }
        }
        if (BOTH(0)) GRID_BAR();
    }
    if (IN(1)) {
        pg8::Gemm g{HB, (const bf16_t*)(ws + W_QKV0), MTOK, NQKV0, DM}; pg8::StaticOrder S; S.init(MTOK, NQKV0, G, bx);
        pg8::EpiQKV E{0, ssp, a_q_gain, a_k_gain, QKV, nullptr};
        pg8::gemm_phase<pg8::EpiQKV, pg8::StaticOrder, true, true>(lds, g, S, E);
        {
            const int nun = (MTOK / 256) * (NQKV0 / 256), full = nun % G, nidle = full ? G - full : G;
            if (bx >= full || full == 0) { const int iw = ((full ? bx - full : bx) * NWAVES + wave), NIW = nidle * NWAVES;
                for (int it = NITEMS_A + iw; it < NITEMS; it += NIW) P0_ITEM(it); }
        }
        if (BOTH(1)) GRID_BAR();
    }
    if (IN(2)) {
        const int nit = 768, perw = (nit + G - 1) / G;
        for (int k = 0; k < 3; ++k) {
            int item;
            if (G == 256) item = (k == 0) ? vcu : 256 + 2 * vcu + (k - 1);
            else { item = vcu * perw + k; if (k >= perw || item >= nit) break; }
            int g, sq, i0, R;
            if (item < 128) { g = 0; sq = item >> 2; i0 = (item & 3) * 32; R = 4; }
            else if (item < 256) { g = 1; sq = item - 128; i0 = 0; R = 4; }
            else { g = 2; sq = item - 256; i0 = 0; R = 1; }
            const int sh = 2 * g, dil = 1 << sh, Lg = SEQ >> sh, hh = sq & 7, vb = sq >> 3, b = vb >> sh, c = vb & (dil - 1);
            att::StreamDesc U;
            const size_t seqoff = (size_t)sq * Lg * 64;
            U.Q = QKV + (size_t)(0 * 3 + g) * ((size_t)MTOK * 512) + seqoff; U.K = QKV + (size_t)(1 * 3 + g) * ((size_t)MTOK * 512) + seqoff; U.V = QKV + (size_t)(2 * 3 + g) * ((size_t)MTOK * 512) + seqoff;
            U.i0 = i0; U.R = R; U.tblg = tblA + (size_t)(g * 8 + hh) * TBLA_N;
            U.O = OG + (size_t)g * ((size_t)MTOK * 512) + hh * 64; U.o_row0 = b * SEQ + c; U.o_rstride = dil;
            U.L = la + (size_t)g * ((size_t)MTOK * 8) + hh;
            att::stream(lds, U);
        }
        if (BOTH(2)) GRID_BAR();
    }
    if (IN(3)) {
        const int gt = vcu * 512 + tid, NGT = G * 512;
#pragma unroll 4
        for (int e = gt; e < MTOK * 64; e += NGT) {
            const int row = e >> 6, c8 = e & 63, hh = c8 >> 3;
            float acc8[8] = {0.f, 0.f, 0.f, 0.f, 0.f, 0.f, 0.f, 0.f}; float l = 0.f;
#pragma unroll
            for (int g = 0; g < 3; ++g) { const u32x4 w = *(const u32x4*)(OG + (size_t)g * ((size_t)MTOK * 512) + (size_t)row * 512 + c8 * 8);
                l += la[(size_t)g * ((size_t)MTOK * 8) + (size_t)row * 8 + hh];
#pragma unroll
                for (int k = 0; k < 4; ++k) { acc8[2 * k] += __builtin_bit_cast(float, w[k] << 16); acc8[2 * k + 1] += __builtin_bit_cast(float, w[k] & 0xffff0000u); } }
            const float rl = 1.f / l; u32x4 o;
            o.x = cvtpk(acc8[0] * rl, acc8[1] * rl); o.y = cvtpk(acc8[2] * rl, acc8[3] * rl); o.z = cvtpk(acc8[4] * rl, acc8[5] * rl); o.w = cvtpk(acc8[6] * rl, acc8[7] * rl);
            *(u32x4*)(O0 + (size_t)row * 512 + c8 * 8) = o;
        }
        if (BOTH(3)) GRID_BAR();
    }
    if (IN(4)) {
        pg8::Gemm g{O0, (const bf16_t*)(ws + W_O0), MTOK, DM, NO0}; pg8::StaticOrder S; S.init(MTOK, DM, G, bx);
        pg8::EpiRes<0> E{x, out, HB, ssp};
        pg8::gemm_phase<pg8::EpiRes<0>, pg8::StaticOrder, false, true>(lds, g, S, E);
        if (BOTH(4)) GRID_BAR();
    }
#define UP_PHASE(PU, WUP) \
    if (IN(PU)) { pg8::Gemm g{HB, (const bf16_t*)(ws + (WUP)), MTOK, FF, DM}; pg8::StaticOrder S; S.init(MTOK, FF, G, bx); pg8::EpiUp E{ssp, HH}; \
        pg8::gemm_phase<pg8::EpiUp, pg8::StaticOrder, true, true>(lds, g, S, E); if (BOTH(PU)) GRID_BAR(); }
#define DN_PHASE(PD, WDN, MODE) \
    if (IN(PD)) { pg8::Gemm g{HH, (const bf16_t*)(ws + (WDN)), MTOK, DM, FF}; pg8::StaticOrder S; S.init(MTOK, DM, G, bx); pg8::EpiRes<MODE> E{nullptr, out, HB, ssp}; \
        pg8::gemm_phase<pg8::EpiRes<MODE>, pg8::StaticOrder, false, true>(lds, g, S, E); if (BOTH(PD)) GRID_BAR(); }
    UP_PHASE(5, W_UP0)
    DN_PHASE(6, W_DN0, 1)
    if (IN(7)) {
        pg8::Gemm g{HB, (const bf16_t*)(ws + W_QKV1), MTOK, NQKV1, DM}; pg8::StaticOrder S; S.init(MTOK, NQKV1, G, bx);
        pg8::EpiQKV E{1, ssp, b_q_gain, b_k_gain, QKV, kmp};
        pg8::gemm_phase<pg8::EpiQKV, pg8::StaticOrder, true, true>(lds, g, S, E);
        if (BOTH(7)) GRID_BAR();
    }
    if (IN(8)) {
        const int per = (512 + G - 1) / G;
        for (int i = 0; i < per; ++i) {
            int bh, p;
            if (per == 2) { const int s = vcu & 3; bh = vcu >> 2; p = (i == 0) ? s : 7 - s; }
            else { const int uid = vcu * per + i; if (uid >= 512) break; bh = uid >> 3; p = uid & 7; }
            const int b = bh >> 4, h = bh & 15;
            const size_t seqoff = (size_t)bh * SEQ * 64;
            att::moba_pair(lds, p, QKV + seqoff, QKV + (size_t)MTOK * 1024 + seqoff, QKV + (size_t)2 * MTOK * 1024 + seqoff, tblB + (size_t)h * TBLB_N,
                           kmp + (((size_t)0 * BATCH + b) * 16 * 16 + h) * 64, kmp + (((size_t)1 * BATCH + b) * 16 * 16 + h) * 64, O1 + (size_t)(b * SEQ) * 1024 + h * 64);
        }
        if (BOTH(8)) GRID_BAR();
    }
    if (IN(9)) {
        pg8::Gemm g{O1, (const bf16_t*)(ws + W_O1), MTOK, DM, NO1}; pg8::StaticOrder S; S.init(MTOK, DM, G, bx);
        pg8::EpiRes<1> E{nullptr, out, HB, ssp};
        pg8::gemm_phase<pg8::EpiRes<1>, pg8::StaticOrder, false, true>(lds, g, S, E);
        if (BOTH(9)) GRID_BAR();
    }
    UP_PHASE(10, W_UP1)
    DN_PHASE(11, W_DN1, 2)
#undef IN
#undef BOTH
}

extern "C" void kernel_launch(void* const* d_in, const int* in_sizes, int n_in, void* d_out, int out_size, void* d_ws, size_t ws_size, hipStream_t stream) {
    static int grid = 0;
    if (grid == 0) {
        if (n_in != 14 || in_sizes[0] != MTOK * DM || out_size != MTOK * DM || ws_size < WS_END) { fprintf(stderr, "kernel_launch: unexpected shapes (n_in %d, in0 %d, out %d, ws %zu); nothing launched\n", n_in, n_in > 0 ? in_sizes[0] : -1, out_size, ws_size); grid = -1; return; }
        int dev = 0, cus = 0, per_cu = 0;
        if (hipGetDevice(&dev) != hipSuccess || hipDeviceGetAttribute(&cus, hipDeviceAttributeMultiprocessorCount, dev) != hipSuccess) { fprintf(stderr, "kernel_launch: device query failed\n"); grid = -1; return; }
        if (hipFuncSetAttribute((const void*)hybrid_fwd, hipFuncAttributeMaxDynamicSharedMemorySize, LDS_BYTES) != hipSuccess) { fprintf(stderr, "kernel_launch: hipFuncSetAttribute failed\n"); grid = -1; return; }
        if (hipOccupancyMaxActiveBlocksPerMultiprocessor(&per_cu, (const void*)hybrid_fwd, NWAVES * 64, LDS_BYTES) != hipSuccess || per_cu < 1) fprintf(stderr, "kernel_launch: note: occupancy query reports %d workgroups per CU\n", per_cu);
        (void)hipGetLastError();
        grid = cus;
        if (grid != 256) { fprintf(stderr, "kernel_launch: built for a 256-CU device, found %d CUs; nothing launched\n", cus); grid = -1; return; }
    }
    if (grid < 0) return;
    if (hipMemsetAsync((char*)d_ws + WS_CTL, 0, CTL_ZERO_BYTES, stream) != hipSuccess) { fprintf(stderr, "kernel_launch: hipMemsetAsync failed\n"); return; }
    Args a{};
    for (int i = 0; i < 14; ++i) a.in[i] = (const float*)d_in[i];
    a.out = (float*)d_out; a.ws = (unsigned char*)d_ws;
    if (N_LAUNCHES == 1) { a.ph_lo = 0; a.ph_hi = PER_PHASE; a.li = 0; hipLaunchKernelGGL(hybrid_fwd, dim3(grid), dim3(NWAVES * 64), LDS_BYTES, stream, a); }
    else for (int li = 0; li < PER_PHASE; ++li) { a.ph_lo = li; a.ph_hi = li + 1; a.li = li; hipLaunchKernelGGL(hybrid_fwd, dim3(grid), dim3(NWAVES * 64), LDS_BYTES, stream, a); }
    const hipError_t le = hipPeekAtLastError();
    if (le != hipSuccess) fprintf(stderr, "kernel_launch: launch failed: %s\n", hipGetErrorName(le));
}
```

```cpp
#include <hip/hip_runtime.h>
#include <cstdio>
#include <cstdint>

#define LAS __attribute__((address_space(3)))
#define GAS __attribute__((address_space(1)))
typedef unsigned short bf16_t;
typedef short bf16x8 __attribute__((ext_vector_type(8)));
typedef short s16x4 __attribute__((ext_vector_type(4)));
typedef float f32x4 __attribute__((ext_vector_type(4)));
typedef float f32x2 __attribute__((ext_vector_type(2)));
typedef float f32x16 __attribute__((ext_vector_type(16)));
typedef unsigned u32x4 __attribute__((ext_vector_type(4)));
typedef unsigned u32x2 __attribute__((ext_vector_type(2)));
typedef __bf16 bf16x2_t __attribute__((ext_vector_type(2)));

constexpr int BATCH = 4, SEQ = 4096, DM = 1024, MTOK = BATCH * SEQ, FF = 4096, HD = 64;
constexpr int NQKV0 = 4608, NO0 = 512, NQKV1 = 3072, NO1 = 1024;
constexpr float EPS = 1e-6f, LOG2E = 1.4426950408889634f, QSCALE = 0.125f * LOG2E, NEGV = -1e30f;
constexpr int TBLB_N = 4352, TBLA_N = 640, TOFF = 255;

__device__ __forceinline__ unsigned cvtpk(float lo, float hi) { f32x2 v = {lo, hi}; bf16x2_t b = __builtin_convertvector(v, bf16x2_t); return __builtin_bit_cast(unsigned, b); }
__device__ __forceinline__ float bf2f(unsigned short h) { return __builtin_bit_cast(float, (unsigned)h << 16); }
__device__ __forceinline__ float rsq(float x) { return __builtin_amdgcn_rsqf(x); }

namespace pg8 {
constexpr int BM = 256, BK = 64, HALF = 128, HTB = HALF * BK * 2, STAGE_BYTES = 8 * HTB, NXCD = 8, WGM = 4;
__host__ __device__ __forceinline__ int lds_byte(int r, int c) { const int st = (r >> 4) * 2 + (c >> 5), rr = r & 15, cc = c & 31, ob = rr * 64 + cc * 2; return st * 1024 + (ob ^ (((ob >> 9) & 1) << 5)); }
__host__ __device__ __forceinline__ void stage_rc(int b, int& R, int& C) { const int st = b / 1024, sb = b % 1024, swz = sb ^ (((sb >> 9) & 1) << 5); R = (st >> 1) * 16 + swz / 64; C = (st & 1) * 32 + (swz % 64) / 2; }
__host__ __device__ __forceinline__ int perm32(int rho) { const int n = rho >> 4, i = rho & 15; return 8 * (i >> 2) + 4 * n + (i & 3); }
struct Unit { int pm, pn; };
struct Gemm { const bf16_t* A; const bf16_t* Bt; int M, N, K; };
struct StaticOrder {
    int nM, nN, nwg, G, c;
    __host__ __device__ void init(int M, int N, int G_, int c_) { nM = M / BM; nN = N / BM; nwg = nM * nN; G = G_; c = c_; }
    __host__ __device__ bool next(int i, Unit& u) const {
        const long L = (long)i * G + c; if (L >= nwg) return false;
        int wgid = (int)L; { const int q = nwg / NXCD, r = nwg % NXCD, xcd = wgid % NXCD, off = wgid / NXCD; wgid = (xcd < r ? xcd * (q + 1) : r * (q + 1) + (xcd - r) * q) + off; }
        const int nig = WGM * nN, gid = wgid / nig, fm = gid * WGM, gsz = (nM - fm) < WGM ? (nM - fm) : WGM;
        u.pm = fm + ((wgid % nig) % gsz); u.pn = (wgid % nig) / gsz; return true;
    }
};

struct EpiQKV {
    static constexpr bool PERM = true, AFTER_DRAIN = false;
    int layer; const float* ssp; const float* gq; const float* gk; bf16_t* dst; float* kmp;
    __device__ __forceinline__ void operator()(const f32x4 (&acc)[2][2][4][2], const Unit& u, int wr, int wc, int fr, int fq) const {
        const int pn = u.pn, pm = u.pm; int kind, hh, g = 0;
        if (layer == 0) { kind = pn / 6; const int rem = pn % 6; g = rem >> 1; hh = (rem & 1) * 4 + wc; } else { kind = pn >> 2; hh = (pn & 3) * 4 + wc; }
        f32x4 gv[2][2]; const float* gp = (kind == 0) ? gq : gk;
#pragma unroll
        for (int bj = 0; bj < 2; ++bj)
#pragma unroll
            for (int n = 0; n < 2; ++n) gv[bj][n] = *(const f32x4*)(gp + 32 * bj + 8 * fq + 4 * n);
        f32x4 cs[2][2];
#pragma unroll
        for (int bj = 0; bj < 2; ++bj)
#pragma unroll
            for (int n = 0; n < 2; ++n) cs[bj][n] = (f32x4){0.f, 0.f, 0.f, 0.f};
        const bool km = (layer == 1 && kind == 1);
#pragma unroll
        for (int ai = 0; ai < 2; ++ai)
#pragma unroll
            for (int m = 0; m < 4; ++m) {
                const int row = pm * BM + ai * HALF + wr * 64 + m * 16 + fr;
                const f32x4 pv = *(const f32x4*)(ssp + (size_t)row * 4);
                const float r = rsq(((pv[0] + pv[1]) + (pv[2] + pv[3])) * (1.f / 1024.f) + EPS);
                f32x4 v[2][2];
#pragma unroll
                for (int bj = 0; bj < 2; ++bj)
#pragma unroll
                    for (int n = 0; n < 2; ++n) v[bj][n] = acc[ai][bj][m][n] * r;
                if (kind < 2) {
                    float s = 0.f;
#pragma unroll
                    for (int bj = 0; bj < 2; ++bj)
#pragma unroll
                        for (int n = 0; n < 2; ++n) { const f32x4 x = v[bj][n]; s += (x[0] * x[0] + x[1] * x[1]) + (x[2] * x[2] + x[3] * x[3]); }
                    s += __shfl_xor(s, 16); s += __shfl_xor(s, 32);
                    float rn = rsq(s * (1.f / 64.f) + EPS); if (kind == 0) rn *= QSCALE;
#pragma unroll
                    for (int bj = 0; bj < 2; ++bj)
#pragma unroll
                        for (int n = 0; n < 2; ++n) { v[bj][n] = v[bj][n] * rn * gv[bj][n]; if (km) cs[bj][n] += v[bj][n]; }
                }
                const int b = row >> 12, t = row & 4095; size_t off;
                if (layer == 0) { const int sh = 2 * g, c = t & ((1 << sh) - 1), l = t >> sh;
                    off = (size_t)(kind * 3 + g) * ((size_t)MTOK * 512) + ((((size_t)((b << sh) + c)) * 8 + hh) * (size_t)(4096 >> sh) + l) * 64; }
                else off = (size_t)kind * ((size_t)MTOK * 1024) + (((size_t)b * 16 + hh) * 4096 + t) * 64;
                bf16_t* p = dst + off + 8 * fq;
#pragma unroll
                for (int bj = 0; bj < 2; ++bj) { u32x4 w; w.x = cvtpk(v[bj][0][0], v[bj][0][1]); w.y = cvtpk(v[bj][0][2], v[bj][0][3]); w.z = cvtpk(v[bj][1][0], v[bj][1][1]); w.w = cvtpk(v[bj][1][2], v[bj][1][3]);
                    *(u32x4*)(p + 32 * bj) = w; }
            }
        if (km) {
#pragma unroll
            for (int bj = 0; bj < 2; ++bj)
#pragma unroll
                for (int n = 0; n < 2; ++n)
#pragma unroll
                    for (int e = 0; e < 4; ++e) { float x = cs[bj][n][e]; x += __shfl_xor(x, 1); x += __shfl_xor(x, 2); x += __shfl_xor(x, 4); x += __shfl_xor(x, 8); cs[bj][n][e] = x; }
            if (fr == 0) { const int b = pm >> 4, nb = pm & 15; float* kp = kmp + ((((size_t)wr * BATCH + b) * 16 + nb) * 16 + hh) * 64 + 8 * fq;
#pragma unroll
                for (int bj = 0; bj < 2; ++bj)
#pragma unroll
                    for (int n = 0; n < 2; ++n) *(f32x4*)(kp + 32 * bj + 4 * n) = cs[bj][n]; }
        }
    }
};
struct EpiUp {
    static constexpr bool PERM = true, AFTER_DRAIN = false;
    const float* ssp; bf16_t* H;
    __device__ __forceinline__ void operator()(const f32x4 (&acc)[2][2][4][2], const Unit& u, int wr, int wc, int fr, int fq) const {
#pragma unroll
        for (int ai = 0; ai < 2; ++ai)
#pragma unroll
            for (int m = 0; m < 4; ++m) {
                const int row = u.pm * BM + ai * HALF + wr * 64 + m * 16 + fr;
                const f32x4 pv = *(const f32x4*)(ssp + (size_t)row * 4);
                const float r = rsq(((pv[0] + pv[1]) + (pv[2] + pv[3])) * (1.f / 1024.f) + EPS);
                bf16_t* rowp = H + (size_t)row * FF + u.pn * BM + wc * 32 + 8 * fq;
#pragma unroll
                for (int bj = 0; bj < 2; ++bj) { f32x4 v0 = acc[ai][bj][m][0] * r, v1 = acc[ai][bj][m][1] * r;
#pragma unroll
                    for (int e = 0; e < 4; ++e) { const float a = fmaxf(v0[e], 0.f), b = fmaxf(v1[e], 0.f); v0[e] = a * a; v1[e] = b * b; }
                    u32x4 w; w.x = cvtpk(v0[0], v0[1]); w.y = cvtpk(v0[2], v0[3]); w.z = cvtpk(v1[0], v1[1]); w.w = cvtpk(v1[2], v1[3]);
                    *(u32x4*)(rowp + bj * HALF) = w; }
            }
    }
};
template <int MODE> struct EpiRes {
    static constexpr bool PERM = true, AFTER_DRAIN = true;
    const float* basef; float* out; bf16_t* hb; float* ssp;
    __device__ __forceinline__ void fused(f32x4 (&acc)[2][2][4][2], const Unit& u, int wr, int wc, int fr, int fq, LAS unsigned char* lds, int wid, int lane) const {
        LAS float* P = (LAS float*)lds;
        const int col0 = u.pn * BM + wc * 32 + 8 * fq;
#pragma unroll
        for (int ai = 0; ai < 2; ++ai)
#pragma unroll
            for (int m = 0; m < 4; ++m) {
                const int rl = ai * HALF + wr * 64 + m * 16 + fr; const size_t off = (size_t)(u.pm * BM + rl) * DM + col0; float s = 0.f;
                f32x4 bv[2][2];
#pragma unroll
                for (int bj = 0; bj < 2; ++bj) {
                    if (MODE == 0) { bv[bj][0] = *(const f32x4*)(basef + off + bj * HALF); bv[bj][1] = *(const f32x4*)(basef + off + bj * HALF + 4); }
                    else { const u32x4 w = *(const u32x4*)(hb + off + bj * HALF);
                        bv[bj][0] = (f32x4){__builtin_bit_cast(float, w.x << 16), __builtin_bit_cast(float, w.x & 0xffff0000u), __builtin_bit_cast(float, w.y << 16), __builtin_bit_cast(float, w.y & 0xffff0000u)};
                        bv[bj][1] = (f32x4){__builtin_bit_cast(float, w.z << 16), __builtin_bit_cast(float, w.z & 0xffff0000u), __builtin_bit_cast(float, w.w << 16), __builtin_bit_cast(float, w.w & 0xffff0000u)}; } }
#pragma unroll
                for (int bj = 0; bj < 2; ++bj) { const f32x4 h0 = bv[bj][0] + acc[ai][bj][m][0], h1 = bv[bj][1] + acc[ai][bj][m][1];
                    if (MODE == 2) { *(f32x4*)(out + off + bj * HALF) = h0; *(f32x4*)(out + off + bj * HALF + 4) = h1; }
                    else { u32x4 w; w.x = cvtpk(h0[0], h0[1]); w.y = cvtpk(h0[2], h0[3]); w.z = cvtpk(h1[0], h1[1]); w.w = cvtpk(h1[2], h1[3]); *(u32x4*)(hb + off + bj * HALF) = w;
                        s += ((h0[0] * h0[0] + h0[1] * h0[1]) + (h0[2] * h0[2] + h0[3] * h0[3])) + ((h1[0] * h1[0] + h1[1] * h1[1]) + (h1[2] * h1[2] + h1[3] * h1[3])); } }
                if (MODE != 2) { s += __shfl_xor(s, 16); s += __shfl_xor(s, 32); if (fq == 0) P[rl * 4 + wc] = s; }
                asm volatile("" ::: "memory");
            }
        if (MODE != 2) {
            asm volatile("s_waitcnt lgkmcnt(0)" ::: "memory"); __builtin_amdgcn_s_barrier(); asm volatile("" ::: "memory");
            const int t = wid * 64 + lane;
            if (t < 256) { const f32x4 p = *(const LAS f32x4*)(P + t * 4); ssp[(size_t)(u.pm * BM + t) * 4 + u.pn] = (p[0] + p[1]) + (p[2] + p[3]); }
        }
    }
};

template <class Epi, class Sched, bool ALIGN_EPI = false, bool SP2 = false>
__device__ __forceinline__ void gemm_phase(LAS unsigned char* lds, const Gemm g, const Sched& S, const Epi& E) {
    const int tid = threadIdx.x, wid = __builtin_amdgcn_readfirstlane(tid >> 6), lane = tid & 63, wr = wid >> 2, wc = wid & 3, fr = lane & 15, fq = lane >> 4;
    const int K = g.K, nt = K / BK;
    unsigned voffA[2], voffB[2];
#pragma unroll
    for (int i = 0; i < 2; ++i) { int R, C; stage_rc(tid * 16 + i * 8192, R, C); const int Rb = Epi::PERM ? ((R & ~31) + perm32(R & 31)) : R;
        voffA[i] = (unsigned)(R * K + C) * 2u; voffB[i] = (unsigned)(Rb * K + C) * 2u; }
    const size_t kstep = (size_t)(BK * 2);
    const size_t hstep = (size_t)HALF * K * 2;
    const size_t tstep = 2 * hstep;
    const unsigned ldsw = (unsigned)wid * 1024u;
    const int aoff = lds_byte(wr * 64 + fr, fq * 8), boff = lds_byte(wc * 32 + fr, fq * 8);
#define PG8_SA(b, h) (((b) * 2 + (h)) * HTB)
#define PG8_SB(b, h) ((4 + (b) * 2 + (h)) * HTB)
#define PG8_STAGE(bufoff, gbase, voff) do { _Pragma("unroll") for (int _i = 0; _i < 2; ++_i) \
        __builtin_amdgcn_global_load_lds((const unsigned*)((const char*)(gbase) + (voff)[_i]), (LAS unsigned*)(lds + (bufoff) + ldsw + _i * 8192), 16, 0, 0); } while (0)
#define PG8_LDA(dst, b, h) do { _Pragma("unroll") for (int m = 0; m < 4; ++m) _Pragma("unroll") for (int k = 0; k < 2; ++k) dst[m][k] = *(const LAS bf16x8*)(lds + PG8_SA(b, h) + aoff + m * 2048 + k * 1024); } while (0)
#define PG8_LDB(dst, b, h) do { _Pragma("unroll") for (int n = 0; n < 2; ++n) _Pragma("unroll") for (int k = 0; k < 2; ++k) dst[n][k] = *(const LAS bf16x8*)(lds + PG8_SB(b, h) + boff + n * 2048 + k * 1024); } while (0)
#define PG8_MMA(ai, bj, At, Bt) do { __builtin_amdgcn_s_setprio(1); _Pragma("unroll") for (int m = 0; m < 4; ++m) _Pragma("unroll") for (int n = 0; n < 2; ++n) _Pragma("unroll") for (int k = 0; k < 2; ++k) \
        acc[ai][bj][m][n] = __builtin_amdgcn_mfma_f32_16x16x32_bf16(Bt[n][k], At[m][k], acc[ai][bj][m][n], 0, 0, 0); __builtin_amdgcn_s_setprio(0); } while (0)
#define PG8_WAIT_V(n) asm volatile("s_waitcnt vmcnt(" #n ")" ::: "memory")
#define PG8_WAIT_L(n) asm volatile("s_waitcnt lgkmcnt(" #n ")" ::: "memory")
#define PG8_BAR __builtin_amdgcn_s_barrier()
#define PG8_SCHED __builtin_amdgcn_sched_barrier(0)
    Unit cur, nxt; int ui = 0;
    if (!S.next(0, cur)) return;
    f32x4 acc[2][2][4][2];
#pragma unroll
    for (int a = 0; a < 2; ++a)
#pragma unroll
        for (int b = 0; b < 2; ++b)
#pragma unroll
            for (int m = 0; m < 4; ++m)
#pragma unroll
                for (int n = 0; n < 2; ++n) acc[a][b][m][n] = (f32x4){0.f, 0.f, 0.f, 0.f};
    bf16x8 At[4][2], B0[2][2], B1[2][2];
    const char* cA = (const char*)g.A + (size_t)cur.pm * tstep; const char* cB = (const char*)g.Bt + (size_t)cur.pn * tstep;
    if constexpr (SP2) {
        PG8_STAGE(PG8_SB(0, 0), cB, voffB); PG8_STAGE(PG8_SB(0, 1), cB + hstep, voffB); PG8_STAGE(PG8_SA(0, 0), cA, voffA); PG8_STAGE(PG8_SA(0, 1), cA + hstep, voffA);
        if (wr == 1) PG8_BAR;
        PG8_WAIT_V(2); PG8_BAR;
        PG8_STAGE(PG8_SB(1, 0), cB + kstep, voffB); PG8_STAGE(PG8_SA(1, 0), cA + kstep, voffA); PG8_STAGE(PG8_SB(1, 1), cB + hstep + kstep, voffB);
        PG8_WAIT_V(6); PG8_BAR;
    } else {
        PG8_STAGE(PG8_SB(0, 0), cB, voffB); PG8_STAGE(PG8_SA(0, 0), cA, voffA); PG8_STAGE(PG8_SB(0, 1), cB + hstep, voffB); PG8_STAGE(PG8_SA(0, 1), cA + hstep, voffA);
        if (wr == 1) PG8_BAR;
        PG8_WAIT_V(4); PG8_BAR;
        PG8_STAGE(PG8_SB(1, 0), cB + kstep, voffB); PG8_STAGE(PG8_SA(1, 0), cA + kstep, voffA); PG8_STAGE(PG8_SB(1, 1), cB + hstep + kstep, voffB);
        PG8_WAIT_V(6); PG8_BAR;
    }
    for (;;) {
        const bool has_next = S.next(ui + 1, nxt);
        const char* nA = has_next ? (const char*)g.A + (size_t)nxt.pm * tstep : cA; const char* nB = has_next ? (const char*)g.Bt + (size_t)nxt.pn * tstep : cB;
        for (int t = 0; t < nt; t += 2) {
            const bool last = (t == nt - 2);
            const char* a1 = cA + (size_t)(t + 1) * kstep;
            const char* a2 = last ? nA : cA + (size_t)(t + 2) * kstep; const char* b2 = last ? nB : cB + (size_t)(t + 2) * kstep;
            const char* a3 = a2 + kstep; const char* b3 = b2 + kstep;
            if constexpr (SP2) {
            PG8_LDB(B0, 0, 0); PG8_LDB(B1, 0, 1); PG8_SCHED; PG8_LDA(At, 0, 0); PG8_STAGE(PG8_SA(1, 1), a1 + hstep, voffA);
            PG8_WAIT_V(8); PG8_WAIT_L(0); PG8_BAR; PG8_MMA(0, 0, At, B0); PG8_MMA(0, 1, At, B1); PG8_BAR; PG8_SCHED;
            PG8_LDA(At, 0, 1); PG8_STAGE(PG8_SB(0, 0), b2, voffB); PG8_STAGE(PG8_SB(0, 1), b2 + hstep, voffB); PG8_STAGE(PG8_SA(0, 0), a2, voffA);
            PG8_WAIT_V(8); PG8_WAIT_L(0); PG8_BAR; PG8_MMA(1, 0, At, B0); PG8_MMA(1, 1, At, B1); PG8_BAR; PG8_SCHED;
            PG8_LDB(B0, 1, 0); PG8_LDB(B1, 1, 1); PG8_SCHED; PG8_LDA(At, 1, 0); PG8_STAGE(PG8_SA(0, 1), a2 + hstep, voffA);
            PG8_WAIT_V(8); PG8_WAIT_L(0); PG8_BAR; PG8_MMA(0, 0, At, B0); PG8_MMA(0, 1, At, B1); PG8_BAR; PG8_SCHED;
            PG8_LDA(At, 1, 1); PG8_STAGE(PG8_SB(1, 0), b3, voffB); PG8_STAGE(PG8_SB(1, 1), b3 + hstep, voffB); PG8_STAGE(PG8_SA(1, 0), a3, voffA);
            PG8_WAIT_V(8); PG8_WAIT_L(0); PG8_BAR; PG8_MMA(1, 0, At, B0); PG8_MMA(1, 1, At, B1); PG8_BAR; PG8_SCHED;
            } else {
            PG8_LDB(B0, 0, 0); PG8_SCHED; PG8_LDA(At, 0, 0); PG8_STAGE(PG8_SA(1, 1), a1 + hstep, voffA);
            PG8_WAIT_L(8); PG8_BAR; PG8_WAIT_L(0); PG8_MMA(0, 0, At, B0); PG8_BAR; PG8_SCHED;
            PG8_LDB(B1, 0, 1); PG8_STAGE(PG8_SB(0, 0), b2, voffB);
            PG8_BAR; PG8_WAIT_L(0); PG8_MMA(0, 1, At, B1); PG8_BAR;
            PG8_LDA(At, 0, 1); PG8_STAGE(PG8_SA(0, 0), a2, voffA);
            PG8_BAR; PG8_WAIT_L(0); PG8_MMA(1, 0, At, B0); PG8_BAR; PG8_SCHED;
            PG8_STAGE(PG8_SB(0, 1), b2 + hstep, voffB);
            PG8_WAIT_V(6); PG8_BAR; PG8_MMA(1, 1, At, B1); PG8_BAR;
            PG8_LDB(B0, 1, 0); PG8_SCHED; PG8_LDA(At, 1, 0); PG8_STAGE(PG8_SA(0, 1), a2 + hstep, voffA);
            PG8_WAIT_L(8); PG8_BAR; PG8_WAIT_L(0); PG8_MMA(0, 0, At, B0); PG8_BAR; PG8_SCHED;
            PG8_LDB(B1, 1, 1); PG8_STAGE(PG8_SB(1, 0), b3, voffB);
            PG8_BAR; PG8_WAIT_L(0); PG8_MMA(0, 1, At, B1); PG8_BAR;
            PG8_LDA(At, 1, 1); PG8_STAGE(PG8_SA(1, 0), a3, voffA);
            PG8_BAR; PG8_WAIT_L(0); PG8_MMA(1, 0, At, B0); PG8_BAR; PG8_SCHED;
            PG8_STAGE(PG8_SB(1, 1), b3 + hstep, voffB);
            PG8_WAIT_V(6); PG8_BAR; PG8_MMA(1, 1, At, B1); PG8_BAR;
            }
        }
        if constexpr (ALIGN_EPI) { if (wr == 0) PG8_BAR; }
        if constexpr (!Epi::AFTER_DRAIN) { E(acc, cur, wr, wc, fr, fq); }
        if (!has_next) break;
#pragma unroll
        for (int a = 0; a < 2; ++a)
#pragma unroll
            for (int b = 0; b < 2; ++b)
#pragma unroll
                for (int m = 0; m < 4; ++m)
#pragma unroll
                    for (int n = 0; n < 2; ++n) acc[a][b][m][n] = (f32x4){0.f, 0.f, 0.f, 0.f};
        cur = nxt; cA = nA; cB = nB; ++ui;
        if constexpr (ALIGN_EPI) { if (wr == 1) PG8_BAR; }
    }
    PG8_WAIT_V(0);
    if constexpr (!ALIGN_EPI) { if (wr == 0) PG8_BAR; }
    PG8_BAR;
    if constexpr (Epi::AFTER_DRAIN) { E.fused(acc, cur, wr, wc, fr, fq, lds, wid, lane); }
#undef PG8_SA
#undef PG8_SB
#undef PG8_STAGE
#undef PG8_LDA
#undef PG8_LDB
#undef PG8_MMA
#undef PG8_WAIT_V
#undef PG8_WAIT_L
#undef PG8_BAR
#undef PG8_SCHED
}
}

namespace att {
constexpr int KB_OFF = 0, VB_OFF = 32768, TBL_OFF = 65536, OST_OFF = 68608, WS_OFF = OST_OFF + 8 * 4096, LDS_END = WS_OFF + 8 * 128;
__device__ __forceinline__ int crow(int r, int hi) { return (r & 3) + 8 * (r >> 2) + 4 * hi; }
#define ATT_WAIT_BAR() asm volatile("s_waitcnt vmcnt(0) lgkmcnt(0)\n\ts_barrier" ::: "memory")
__device__ __forceinline__ void glds16(const void* gsrc, unsigned lds_dst) { unsigned keep;
    asm volatile("s_mov_b32 %0, m0\n\ts_mov_b32 m0, %2\n\ts_nop 0\n\tglobal_load_lds_dwordx4 %1, off\n\ts_mov_b32 m0, %0" : "=&s"(keep) : "v"(gsrc), "s"(lds_dst) : "memory"); }

struct StreamDesc {
    const bf16_t* Q; const bf16_t* K; const bf16_t* V;
    int i0, R;
    const float* tblg;
    bf16_t* O; int o_row0, o_rstride;
    float* L;
};
constexpr int S_KB = 0, S_VB = 49152, S_TBL = 98304, S_OST = 101376, S_WS = S_OST + 8 * 4096, S_END = S_WS + 8 * 128;
__device__ __forceinline__ void stream(LAS unsigned char* lds, const StreamDesc& U) {
    const int tid = threadIdx.x, lane = tid & 63, r32 = lane & 31, hi = lane >> 5; const int wid = __builtin_amdgcn_readfirstlane(tid >> 6);
    LAS float* tbl = (LAS float*)(lds + S_TBL);
    { int t_ = tid; asm volatile("" : "+v"(t_));
      for (int i = t_; i < TBLA_N / 4; i += 512) ((LAS f32x4*)tbl)[i] = ((const f32x4*)U.tblg)[i]; }
    const unsigned lds0 = (unsigned)(uintptr_t)lds;
#define ATT_DMA(t) do { int l_ = lane; asm volatile("" : "+v"(l_)); const int sl_ = (t) % 6; \
        glds16(U.K + (size_t)l_ * 64 + wid * 8 + (size_t)(t) * 4096, (unsigned)__builtin_amdgcn_readfirstlane((int)(lds0 + S_KB + sl_ * 8192 + wid * 1024))); \
        glds16(U.V + (size_t)(16 * (wid & 3) + (l_ >> 2)) * 64 + (wid >> 2) * 32 + (l_ & 3) * 8 + (size_t)(t) * 4096, (unsigned)__builtin_amdgcn_readfirstlane((int)(lds0 + S_VB + sl_ * 8192 + wid * 1024))); } while (0)
    const int t_first = (U.i0 >> 1) - 2 > 0 ? (U.i0 >> 1) - 2 : 0, t_last = (U.i0 >> 1) + 4 * U.R - 1;
    int r = 0;
    int qt = U.i0 + wid;
    bf16x8 qr[4], qn[4];
#pragma unroll
    for (int d0 = 0; d0 < 4; ++d0) { qr[d0] = *(const bf16x8*)(U.Q + (size_t)(qt * 32 + r32) * 64 + d0 * 16 + hi * 8);
        qn[d0] = *(const bf16x8*)(U.Q + (size_t)((U.R > 1 ? qt + 8 : qt) * 32 + r32) * 64 + d0 * 16 + hi * 8); }
    ATT_DMA(t_first); ATT_DMA(t_first + 1);
    f32x16 o[2], ol; o[0] = (f32x16){0.f, 0.f, 0.f, 0.f, 0.f, 0.f, 0.f, 0.f, 0.f, 0.f, 0.f, 0.f, 0.f, 0.f, 0.f, 0.f}; o[1] = o[0]; ol = o[0];
    const int vb0 = (int)(unsigned)(uintptr_t)(lds + S_VB) + ((lane >> 4) & 1) * 32 + (lane & 3) * 8 + (4 * hi + ((lane & 15) >> 2)) * 64;
    const bf16x8 ones = {0x3F80, 0x3F80, 0x3F80, 0x3F80, 0x3F80, 0x3F80, 0x3F80, 0x3F80};
    LAS bf16_t* stg = (LAS bf16_t*)(lds + S_OST) + wid * 2048;
    LAS float* wsl = (LAS float*)(lds + S_WS) + wid * 32;
    ATT_WAIT_BAR();
#define ST_TILE(tt) do { const int kbase_ = (tt) * 64, qrow_ = qt * 32 + r32, sl_ = (tt) % 6; \
        const LAS float* tp_ = tbl + (383 - (qrow_ - kbase_) + 4 * hi); f32x16 p0, p1; \
        _Pragma("unroll") for (int rr = 0; rr < 16; ++rr) { const int cc = (rr & 3) + 8 * (rr >> 2); p0[rr] = tp_[cc]; p1[rr] = tp_[cc + 32]; } \
        const LAS unsigned char* kb_ = lds + S_KB + sl_ * 8192 + hi * 1024 + r32 * 16; \
        _Pragma("unroll") for (int d0 = 0; d0 < 4; ++d0) { const bf16x8 kf0_ = *(const LAS bf16x8*)(kb_ + d0 * 2048), kf1_ = *(const LAS bf16x8*)(kb_ + d0 * 2048 + 512); \
            p0 = __builtin_amdgcn_mfma_f32_32x32x16_bf16(kf0_, qr[d0], p0, 0, 0, 0); p1 = __builtin_amdgcn_mfma_f32_32x32x16_bf16(kf1_, qr[d0], p1, 0, 0, 0); } \
        _Pragma("unroll") for (int rr = 0; rr < 16; ++rr) { p0[rr] = __builtin_amdgcn_exp2f(p0[rr]); p1[rr] = __builtin_amdgcn_exp2f(p1[rr]); } \
        u32x4 pw[4]; \
        _Pragma("unroll") for (int k = 0; k < 2; ++k) { pw[k] = (u32x4){cvtpk(p0[8 * k], p0[8 * k + 1]), cvtpk(p0[8 * k + 2], p0[8 * k + 3]), cvtpk(p0[8 * k + 4], p0[8 * k + 5]), cvtpk(p0[8 * k + 6], p0[8 * k + 7])}; \
            pw[2 + k] = (u32x4){cvtpk(p1[8 * k], p1[8 * k + 1]), cvtpk(p1[8 * k + 2], p1[8 * k + 3]), cvtpk(p1[8 * k + 4], p1[8 * k + 5]), cvtpk(p1[8 * k + 6], p1[8 * k + 7])}; } \
        _Pragma("unroll") for (int ks = 0; ks < 4; ++ks) ol = __builtin_amdgcn_mfma_f32_32x32x16_bf16(__builtin_bit_cast(bf16x8, pw[ks]), ones, ol, 0, 0, 0); \
        const int vb_ = vb0 + sl_ * 8192; \
        _Pragma("unroll") for (int d0 = 0; d0 < 2; ++d0) { s16x4 vlo[4], vhi[4]; \
            _Pragma("unroll") for (int ks = 0; ks < 4; ++ks) { vlo[ks] = __builtin_bit_cast(s16x4, __builtin_amdgcn_ds_read_tr16_b64_v4i16((LAS s16x4*)(uintptr_t)(unsigned)(vb_ + d0 * 4096 + ks * 1024))); \
                                                             vhi[ks] = __builtin_bit_cast(s16x4, __builtin_amdgcn_ds_read_tr16_b64_v4i16((LAS s16x4*)(uintptr_t)(unsigned)(vb_ + d0 * 4096 + ks * 1024 + 512))); } \
            _Pragma("unroll") for (int ks = 0; ks < 4; ++ks) { const bf16x8 vf = (bf16x8){vlo[ks][0], vlo[ks][1], vlo[ks][2], vlo[ks][3], vhi[ks][0], vhi[ks][1], vhi[ks][2], vhi[ks][3]}; \
                o[d0] = __builtin_amdgcn_mfma_f32_32x32x16_bf16(__builtin_bit_cast(bf16x8, pw[ks]), vf, o[d0], 0, 0, 0); } } } while (0)
    int pend_qt = -1;
#define ST_FLUSH() do { if (pend_qt >= 0) { \
        { const float lv = wsl[r32]; float* lp = U.L + (size_t)(U.o_row0 + (pend_qt * 32 + r32) * U.o_rstride) * 8; if (hi == 0) *lp = lv; } \
        _Pragma("unroll") for (int i = 0; i < 4; ++i) { const int row = i * 8 + (lane >> 3), ch = lane & 7; const u32x4 v = *(const LAS u32x4*)(stg + row * 64 + ch * 8); \
            *(u32x4*)(U.O + (size_t)(U.o_row0 + (pend_qt * 32 + row) * U.o_rstride) * 512 + ch * 8) = v; } \
        if (r + 1 < U.R) { _Pragma("unroll") for (int d0 = 0; d0 < 4; ++d0) qn[d0] = *(const bf16x8*)(U.Q + (size_t)((qt + 8) * 32 + r32) * 64 + d0 * 16 + hi * 8); } \
        pend_qt = -1; } } while (0)
    for (int t = t_first; t < t_last; t += 2) {
        if (t + 2 < t_last) { ATT_DMA(t + 2); ATT_DMA(t + 3); }
        ST_FLUSH();
        if (r < U.R) {
            const int wend = qt >> 1;
            const bool a0 = (t >= wend - 2) && (t <= wend), a1 = (t + 1 >= wend - 2) && (t + 1 <= wend);
            if (a0 && a1) { ST_TILE(t); ST_TILE(t + 1); }
            else if (a0) { ST_TILE(t); }
            else if (a1) { ST_TILE(t + 1); }
            if (wend == t || wend == t + 1) {
#pragma unroll
                for (int rr = 0; rr < 16; ++rr) { const int orow = crow(rr, hi);
#pragma unroll
                    for (int d0 = 0; d0 < 2; ++d0) stg[orow * 64 + d0 * 32 + r32] = (bf16_t)(cvtpk(o[d0][rr], 0.f) & 0xffffu);
                    if (r32 == 0) wsl[orow] = ol[rr]; }
                pend_qt = qt; ++r; qt += 8;
                o[0] = (f32x16){0.f, 0.f, 0.f, 0.f, 0.f, 0.f, 0.f, 0.f, 0.f, 0.f, 0.f, 0.f, 0.f, 0.f, 0.f, 0.f}; o[1] = o[0]; ol = o[0];
#pragma unroll
                for (int d0 = 0; d0 < 4; ++d0) qr[d0] = qn[d0];
            }
        }
        ATT_WAIT_BAR();
    }
    ST_FLUSH();
    asm volatile("s_waitcnt vmcnt(0)" ::: "memory");
#undef ST_FLUSH
#undef ATT_DMA
#undef ST_TILE
}

constexpr int D_KB = 0, D_VB = 32768, D_TBL = 65536, D_KM = 82944, D_OST = 91136, D_END = D_OST + 8 * 4096;
__device__ __forceinline__ void moba_pair(LAS unsigned char* lds, int p, const bf16_t* Qs, const bf16_t* Ks, const bf16_t* Vs, const float* tblg, const float* kmp0, const float* kmp1, bf16_t* O) {
    const int tid = threadIdx.x, lane = tid & 63, r32 = lane & 31, hi = lane >> 5; const int wid = __builtin_amdgcn_readfirstlane(tid >> 6);
    LAS float* tbl = (LAS float*)(lds + D_TBL);
    const int qbA = 2 * p, qbB = 2 * p + 1, NT = 8 * p + 8, NTA = 8 * p + 4;
    const unsigned lds0 = (unsigned)(uintptr_t)lds;
#define MD_DMA(t) do { int l_ = lane; asm volatile("" : "+v"(l_)); \
        glds16(Ks + (size_t)l_ * 64 + wid * 8 + (size_t)(t) * 4096, (unsigned)__builtin_amdgcn_readfirstlane((int)(lds0 + D_KB + ((t) & 3) * 8192 + wid * 1024))); \
        glds16(Vs + (size_t)(16 * (wid & 3) + (l_ >> 2)) * 64 + (wid >> 2) * 32 + (l_ & 3) * 8 + (size_t)(t) * 4096, (unsigned)__builtin_amdgcn_readfirstlane((int)(lds0 + D_VB + ((t) & 3) * 8192 + wid * 1024))); } while (0)
    for (int i = tid; i < TBLB_N / 4; i += 512) ((LAS f32x4*)tbl)[i] = ((const f32x4*)tblg)[i];
    {   LAS bf16_t* kmh = (LAS bf16_t*)(lds + D_KM); LAS bf16_t* kml = kmh + 32 * 64;
        for (int i = tid; i < 32 * 64; i += 512) { const int j = i >> 6, d = i & 63; float x = 0.f;
            if (j < qbB) x = (kmp0[(size_t)j * 1024 + d] + kmp1[(size_t)j * 1024 + d]) * (1.f / 256.f);
            const unsigned hb = cvtpk(x, 0.f) & 0xffffu; const float xl = x - bf2f((unsigned short)hb);
            kmh[i] = (bf16_t)hb; kml[i] = (bf16_t)(cvtpk(xl, 0.f) & 0xffffu); } }
    const int qt = (wid < 4) ? wid : 11 - wid;
    const int qrowA = qbA * 256 + qt * 32 + r32, qrowB = qrowA + 256;
    bf16x8 qrA[4], qrB[4];
#pragma unroll
    for (int d0 = 0; d0 < 4; ++d0) { qrA[d0] = *(const bf16x8*)(Qs + (size_t)qrowA * 64 + d0 * 16 + hi * 8); qrB[d0] = *(const bf16x8*)(Qs + (size_t)qrowB * 64 + d0 * 16 + hi * 8); }
    MD_DMA(0); MD_DMA(1);
    ATT_WAIT_BAR();
    MD_DMA(2);
    unsigned selA = 0u, selB = 0u;
#define MD_GATE(SEL, QR, QB) do { f32x16 g0 = {0.f, 0.f, 0.f, 0.f, 0.f, 0.f, 0.f, 0.f, 0.f, 0.f, 0.f, 0.f, 0.f, 0.f, 0.f, 0.f}; \
        const LAS unsigned char* kb_ = lds + D_KM + r32 * 128 + hi * 16; \
        _Pragma("unroll") for (int d0 = 0; d0 < 4; ++d0) { const bf16x8 ah = *(const LAS bf16x8*)(kb_ + d0 * 32), al = *(const LAS bf16x8*)(kb_ + 4096 + d0 * 32); \
            g0 = __builtin_amdgcn_mfma_f32_32x32x16_bf16(ah, QR[d0], g0, 0, 0, 0); g0 = __builtin_amdgcn_mfma_f32_32x32x16_bf16(al, QR[d0], g0, 0, 0, 0); } \
        float gt[16]; \
        _Pragma("unroll") for (int r = 0; r < 8; ++r) { const float mine = g0[r], oth = __shfl_xor(mine, 32); const int jm = (r & 3) + 8 * (r >> 2); gt[jm] = hi ? oth : mine; gt[jm + 4] = hi ? mine : oth; } \
        _Pragma("unroll") for (int rep = 0; rep < 3; ++rep) { float best = -__builtin_inff(); int bi = -1; \
            _Pragma("unroll") for (int j = 0; j < 16; ++j) { const bool ok = (j < (QB)) && !((SEL >> j) & 1u) && (gt[j] > best); if (ok) { best = gt[j]; bi = j; } } \
            if (bi >= 0) SEL |= 1u << bi; } \
        SEL |= 1u << (QB); } while (0)
    MD_GATE(selA, qrA, qbA);
    MD_GATE(selB, qrB, qbB);
    LAS unsigned char* qal = lds + D_OST + wid * 4096 + lane * 16;
#pragma unroll
    for (int d0 = 0; d0 < 4; ++d0) *(LAS bf16x8*)(qal + d0 * 1024) = qrA[d0];
#define QA(d0) (*(const LAS bf16x8*)(qal + (d0) * 1024))
#define QB_(d0) qrB[d0]
    const int vb0 = (int)(unsigned)(uintptr_t)(lds + D_VB) + ((lane >> 4) & 1) * 32 + (lane & 3) * 8 + (4 * hi + ((lane & 15) >> 2)) * 64;
    f32x16 oA[2], oB[2]; float olA = 0.f, olB = 0.f; oA[0] = (f32x16){0.f, 0.f, 0.f, 0.f, 0.f, 0.f, 0.f, 0.f, 0.f, 0.f, 0.f, 0.f, 0.f, 0.f, 0.f, 0.f}; oA[1] = oA[0]; oB[0] = oA[0]; oB[1] = oA[0];
#define MD_QK(P0, P1, SEL, QROW, QR, t) do { const int kb_ = 64 * (t); const bool sel_ = (SEL >> ((t) >> 2)) & 1u; \
        const int base_ = sel_ ? (4095 - (QROW - kb_) + 4 * hi) : (4096 + 4 * hi); const LAS float* tp_ = tbl + base_; \
        _Pragma("unroll") for (int r = 0; r < 16; ++r) { const int cc = (r & 3) + 8 * (r >> 2); P0[r] = tp_[cc]; P1[r] = tp_[cc + 32]; } \
        const LAS unsigned char* kq_ = lds + D_KB + ((t) & 3) * 8192 + hi * 1024 + r32 * 16; \
        _Pragma("unroll") for (int d0 = 0; d0 < 4; ++d0) { const bf16x8 kf0_ = *(const LAS bf16x8*)(kq_ + d0 * 2048), kf1_ = *(const LAS bf16x8*)(kq_ + d0 * 2048 + 512); \
            const bf16x8 qf_ = QR(d0); P0 = __builtin_amdgcn_mfma_f32_32x32x16_bf16(kf0_, qf_, P0, 0, 0, 0); P1 = __builtin_amdgcn_mfma_f32_32x32x16_bf16(kf1_, qf_, P1, 0, 0, 0); } } while (0)
#define MD_EXP(PW, P0, P1, OL) do { float s_ = 0.f; \
        _Pragma("unroll") for (int r = 0; r < 16; ++r) { P0[r] = __builtin_amdgcn_exp2f(P0[r]); P1[r] = __builtin_amdgcn_exp2f(P1[r]); s_ += P0[r] + P1[r]; } OL += s_; \
        _Pragma("unroll") for (int k = 0; k < 2; ++k) { PW[k] = (u32x4){cvtpk(P0[8 * k], P0[8 * k + 1]), cvtpk(P0[8 * k + 2], P0[8 * k + 3]), cvtpk(P0[8 * k + 4], P0[8 * k + 5]), cvtpk(P0[8 * k + 6], P0[8 * k + 7])}; \
            PW[2 + k] = (u32x4){cvtpk(P1[8 * k], P1[8 * k + 1]), cvtpk(P1[8 * k + 2], P1[8 * k + 3]), cvtpk(P1[8 * k + 4], P1[8 * k + 5]), cvtpk(P1[8 * k + 6], P1[8 * k + 7])}; } } while (0)
#define MD_PV(OO, PW, t) do { const int vb_ = vb0 + ((t) & 3) * 8192; \
        _Pragma("unroll") for (int d0 = 0; d0 < 2; ++d0) { s16x4 vlo[4], vhi[4]; \
            _Pragma("unroll") for (int ks = 0; ks < 4; ++ks) { vlo[ks] = __builtin_bit_cast(s16x4, __builtin_amdgcn_ds_read_tr16_b64_v4i16((LAS s16x4*)(uintptr_t)(unsigned)(vb_ + d0 * 4096 + ks * 1024))); \
                                                             vhi[ks] = __builtin_bit_cast(s16x4, __builtin_amdgcn_ds_read_tr16_b64_v4i16((LAS s16x4*)(uintptr_t)(unsigned)(vb_ + d0 * 4096 + ks * 1024 + 512))); } \
            _Pragma("unroll") for (int ks = 0; ks < 4; ++ks) { const bf16x8 vf = (bf16x8){vlo[ks][0], vlo[ks][1], vlo[ks][2], vlo[ks][3], vhi[ks][0], vhi[ks][1], vhi[ks][2], vhi[ks][3]}; \
                OO[d0] = __builtin_amdgcn_mfma_f32_32x32x16_bf16(__builtin_bit_cast(bf16x8, PW[ks]), vf, OO[d0], 0, 0, 0); } } } while (0)
#define MD_SB() __builtin_amdgcn_sched_barrier(0)
    for (int t = 0; t < NT; ++t) {
        const bool dma = (t + 3 < NT);
        if (dma) MD_DMA(t + 3);
        const bool needA = (t < NTA) && (t - 8 * p <= (qt >> 1)), needB = (t < NTA) || (t - NTA <= (qt >> 1));
        if (needA) {
            f32x16 a0, a1, b0, b1; u32x4 pwa[4], pwb[4];
            { const int kb_ = 64 * t; const bool sa_ = (selA >> (t >> 2)) & 1u, sb_ = (selB >> (t >> 2)) & 1u;
              const LAS float* ta_ = tbl + (sa_ ? (4095 - (qrowA - kb_) + 4 * hi) : (4096 + 4 * hi)); const LAS float* tb_ = tbl + (sb_ ? (4095 - (qrowB - kb_) + 4 * hi) : (4096 + 4 * hi));
#pragma unroll
              for (int r = 0; r < 16; ++r) { const int cc = (r & 3) + 8 * (r >> 2); a0[r] = ta_[cc]; a1[r] = ta_[cc + 32]; b0[r] = tb_[cc]; b1[r] = tb_[cc + 32]; }
              const LAS unsigned char* kq_ = lds + D_KB + (t & 3) * 8192 + hi * 1024 + r32 * 16;
#pragma unroll
              for (int d0 = 0; d0 < 4; ++d0) { const bf16x8 kf0_ = *(const LAS bf16x8*)(kq_ + d0 * 2048), kf1_ = *(const LAS bf16x8*)(kq_ + d0 * 2048 + 512); const bf16x8 qa_ = QA(d0), qb_ = qrB[d0];
                  a0 = __builtin_amdgcn_mfma_f32_32x32x16_bf16(kf0_, qa_, a0, 0, 0, 0); a1 = __builtin_amdgcn_mfma_f32_32x32x16_bf16(kf1_, qa_, a1, 0, 0, 0);
                  b0 = __builtin_amdgcn_mfma_f32_32x32x16_bf16(kf0_, qb_, b0, 0, 0, 0); b1 = __builtin_amdgcn_mfma_f32_32x32x16_bf16(kf1_, qb_, b1, 0, 0, 0); } }
            MD_EXP(pwa, a0, a1, olA); MD_EXP(pwb, b0, b1, olB);
            { const int vb_ = vb0 + (t & 3) * 8192;
#pragma unroll
              for (int d0 = 0; d0 < 2; ++d0) { s16x4 vlo[4], vhi[4];
#pragma unroll
                  for (int ks = 0; ks < 4; ++ks) { vlo[ks] = __builtin_bit_cast(s16x4, __builtin_amdgcn_ds_read_tr16_b64_v4i16((LAS s16x4*)(uintptr_t)(unsigned)(vb_ + d0 * 4096 + ks * 1024)));
                                                   vhi[ks] = __builtin_bit_cast(s16x4, __builtin_amdgcn_ds_read_tr16_b64_v4i16((LAS s16x4*)(uintptr_t)(unsigned)(vb_ + d0 * 4096 + ks * 1024 + 512))); }
#pragma unroll
                  for (int ks = 0; ks < 4; ++ks) { const bf16x8 vf = (bf16x8){vlo[ks][0], vlo[ks][1], vlo[ks][2], vlo[ks][3], vhi[ks][0], vhi[ks][1], vhi[ks][2], vhi[ks][3]};
                      oA[d0] = __builtin_amdgcn_mfma_f32_32x32x16_bf16(__builtin_bit_cast(bf16x8, pwa[ks]), vf, oA[d0], 0, 0, 0);
                      oB[d0] = __builtin_amdgcn_mfma_f32_32x32x16_bf16(__builtin_bit_cast(bf16x8, pwb[ks]), vf, oB[d0], 0, 0, 0); } } }
        } else if (needB) {
            f32x16 b0, b1; u32x4 pwb[4];
            MD_QK(b0, b1, selB, qrowB, QB_, t); MD_EXP(pwb, b0, b1, olB); MD_PV(oB, pwb, t);
        }
        if (t + 3 < NT) asm volatile("s_waitcnt vmcnt(4) lgkmcnt(0)\n\ts_barrier" ::: "memory");
        else if (t + 2 < NT) asm volatile("s_waitcnt vmcnt(2) lgkmcnt(0)\n\ts_barrier" ::: "memory");
        else ATT_WAIT_BAR();
    }
    LAS bf16_t* stg = (LAS bf16_t*)(lds + D_OST) + wid * 2048;
    LAS float* wsf = (LAS float*)(lds + D_KM) + wid * 64;
#define MD_OUT(OO, OL, QB) do { { float l_ = OL + __shfl_xor(OL, 32); if (hi == 0) wsf[r32] = __builtin_amdgcn_rcpf(l_); } asm volatile("s_waitcnt lgkmcnt(0)" ::: "memory"); \
        _Pragma("unroll") for (int r = 0; r < 16; ++r) { const int orow = crow(r, hi); const float sc = wsf[orow]; \
            _Pragma("unroll") for (int d0 = 0; d0 < 2; ++d0) stg[orow * 64 + d0 * 32 + r32] = (bf16_t)(cvtpk(OO[d0][r] * sc, 0.f) & 0xffffu); } \
        asm volatile("s_waitcnt lgkmcnt(0)" ::: "memory"); \
        _Pragma("unroll") for (int i = 0; i < 4; ++i) { const int row = i * 8 + (lane >> 3), ch = lane & 7; const u32x4 v = *(const LAS u32x4*)(stg + row * 64 + ch * 8); \
            *(u32x4*)(O + (size_t)((QB) * 256 + qt * 32 + row) * 1024 + ch * 8) = v; } \
        asm volatile("s_waitcnt lgkmcnt(0)" ::: "memory"); } while (0)
    MD_OUT(oA, olA, qbA);
    MD_OUT(oB, olB, qbB);
    ATT_WAIT_BAR();
#undef MD_DMA
#undef MD_GATE
#undef MD_QK
#undef MD_EXP
#undef MD_PV
#undef MD_SB
#undef QA
#undef QB_
#undef MD_OUT
}
}

constexpr int NWAVES = 8;
#ifndef MK_N_LAUNCHES
#define MK_N_LAUNCHES 1
#endif
constexpr int N_LAUNCHES = MK_N_LAUNCHES, PER_PHASE = 12;
constexpr size_t MiB = 1u << 20;
constexpr size_t WS_CTL = 0, CTL_ZERO_BYTES = 32 * 1024;
constexpr size_t WS_SS = 1 * MiB;
constexpr size_t WS_KM = WS_SS + 512 * 1024;
constexpr size_t WS_TBLB = 2 * MiB;
constexpr size_t WS_TBLA = WS_TBLB + 512 * 1024;
constexpr size_t WS_LA = 3 * MiB;
constexpr size_t WS_W = 6 * MiB;
constexpr size_t W_QKV0 = WS_W, W_O0 = W_QKV0 + 9 * MiB, W_QKV1 = W_O0 + 1 * MiB, W_O1 = W_QKV1 + 6 * MiB, W_UP0 = W_O1 + 2 * MiB, W_UP1 = W_UP0 + 8 * MiB, W_DN0 = W_UP1 + 8 * MiB, W_DN1 = W_DN0 + 8 * MiB;
constexpr size_t WS_HB = 56 * MiB;
constexpr size_t WS_OG = 56 * MiB;
constexpr size_t WS_QKV = 104 * MiB;
constexpr size_t WS_O0 = 104 * MiB;
constexpr size_t WS_O1 = 200 * MiB;
constexpr size_t WS_H = 104 * MiB;
constexpr size_t WS_END = 256 * MiB;
static_assert(W_DN1 + 8 * MiB == WS_HB && WS_H + 128 * MiB <= WS_END && WS_QKV + 144 * MiB <= WS_END, "d_ws map");
constexpr int CW_BAR = 4096;
constexpr int RING_BYTES = 131072, LDS_BYTES = 163840, LDSCTL_OFF = LDS_BYTES - 512, MISC_OFF = LDSCTL_OFF + 320;
static_assert(att::S_END <= LDSCTL_OFF && att::D_END <= RING_BYTES, "attention LDS");

typedef GAS unsigned gu32;
#define RLX_AGENT __ATOMIC_RELAXED, __HIP_MEMORY_SCOPE_AGENT
#define XB_TMO      128
#define XB_XCNT(j)  (256  + 64 * (j))
#define XB_XSUB(j)  (1280 + 64 * (j))
#define XB_XGEN(j)  (2304 + 64 * (j))
#define XB_TOP      3328
#define XB_TOPGEN   3392
#define XCD_BAR_WORDS 3456
#define XB_SPIN_CAP (1u << 18)
__device__ __forceinline__ unsigned xb_ld(unsigned* p)              { return __hip_atomic_load(p, __ATOMIC_RELAXED, __HIP_MEMORY_SCOPE_AGENT); }
__device__ __forceinline__ unsigned xb_add(unsigned* p, unsigned v) { return __hip_atomic_fetch_add(p, v, __ATOMIC_RELAXED, __HIP_MEMORY_SCOPE_AGENT); }
__device__ __forceinline__ unsigned xb_xcc_id() { return (unsigned)__builtin_amdgcn_s_getreg((3 << 11) | 20) & 0xFu; }
#define XB_SPIN(cond, bar) do { unsigned _sp = 0; while (cond) { __builtin_amdgcn_s_sleep(1); \
    if ((++_sp & 255u) == 0u) { if (xb_ld(&(bar)[XB_TMO])) break; if (_sp > XB_SPIN_CAP) { atomicAdd(&(bar)[XB_TMO], 1u); break; } } } } while (0)
struct XcdBarrier { unsigned* bar; unsigned x; volatile LAS unsigned* st; };
__device__ __forceinline__ XcdBarrier xcd_barrier_post(unsigned* bar, volatile LAS unsigned* st) {
    XcdBarrier b; b.bar = bar; b.x = xb_xcc_id(); b.st = st;
    if (threadIdx.x == 0) (void)xb_add(&bar[XB_XCNT(b.x)], 1u);
    return b;
}
__device__ __forceinline__ void xcd_barrier_complete(unsigned* bar, unsigned x, unsigned& nloc, unsigned& nx) {
    const unsigned G = gridDim.x * gridDim.y * gridDim.z;
    unsigned sum, cnt, mine, sp = 0u;
    for (;;) {
        sum = 0u; cnt = 0u; mine = 0u;
#pragma unroll
        for (unsigned j = 0; j < 16; ++j) { const unsigned c = xb_ld(&bar[XB_XCNT(j)]); sum += c; cnt += (c > 0u) ? 1u : 0u; mine = (j == x) ? c : mine; }
        if (sum == G) break;
        __builtin_amdgcn_s_sleep(1);
        if ((++sp & 255u) == 0u) { if (xb_ld(&bar[XB_TMO])) break; if (sp > XB_SPIN_CAP) { atomicAdd(&bar[XB_TMO], 1u); break; } }
    }
    nloc = mine > 0u ? mine : 1u; nx = cnt > 0u ? cnt : 1u;
}
__device__ __forceinline__ void xcd_barrier(const XcdBarrier& b) {
    asm volatile("s_waitcnt vmcnt(0)" ::: "memory");
    __syncthreads();
    if (threadIdx.x == 0) {
        unsigned* bar = b.bar;
        __builtin_amdgcn_s_waitcnt(0);
        unsigned nloc = b.st[0], nx = b.st[1];
        if (nloc == 0u) { xcd_barrier_complete(bar, b.x, nloc, nx); b.st[0] = nloc; b.st[1] = nx; }
        const unsigned old = xb_add(&bar[XB_XSUB(b.x)], 1u);
        const unsigned gen = old / nloc;
        if (old + 1u == (gen + 1u) * nloc) {
            __builtin_amdgcn_fence(__ATOMIC_RELEASE, "agent");
            asm volatile("s_waitcnt vmcnt(0)" ::: "memory");
            const unsigned og = xb_add(&bar[XB_TOP], 1u);
            const unsigned tg = og / nx;
            if (og + 1u == (tg + 1u) * nx) xb_add(&bar[XB_TOPGEN], 1u);
            else XB_SPIN(xb_ld(&bar[XB_TOPGEN]) == tg, bar);
            __builtin_amdgcn_fence(__ATOMIC_ACQUIRE, "agent");
            xb_add(&bar[XB_XGEN(b.x)], 1u);
            asm volatile("s_waitcnt vmcnt(0)" ::: "memory");
        } else {
            XB_SPIN(xb_ld(&bar[XB_XGEN(b.x)]) == gen, bar);
            __builtin_amdgcn_fence(__ATOMIC_ACQUIRE, "agent");
            asm volatile("s_waitcnt vmcnt(0)" ::: "memory");
        }
    }
    __syncthreads();
}

__device__ __forceinline__ float wave_sum(float v) {
#pragma unroll
    for (int o = 1; o < 64; o <<= 1) v += __shfl_xor(v, o);
    return v;
}
__device__ __forceinline__ float wave_max(float v) {
#pragma unroll
    for (int o = 1; o < 64; o <<= 1) v = fmaxf(v, __shfl_xor(v, o));
    return v;
}
__device__ __forceinline__ void p0_transpose_item(const float* W, int K, int N, bf16_t* WT, const float* gain, bool perm, LAS float* scr, int item, int lane) {
    const int nblk = N / 32, kb = item / nblk, nb = item % nblk, k0 = 64 * kb, n0 = 32 * nb;
    const int kr = lane >> 3, c4 = (lane & 7) * 4;
    f32x4 v[8]; float gs[8];
#pragma unroll
    for (int i = 0; i < 8; ++i) { v[i] = *(const f32x4*)(W + (size_t)(k0 + 8 * i + kr) * N + n0 + c4); gs[i] = gain ? gain[k0 + 8 * i + kr] : 1.f; }
#pragma unroll
    for (int i = 0; i < 8; ++i) { LAS float* s = scr + (8 * i + kr) * 33 + c4; s[0] = v[i][0] * gs[i]; s[1] = v[i][1] * gs[i]; s[2] = v[i][2] * gs[i]; s[3] = v[i][3] * gs[i]; }
    asm volatile("s_waitcnt lgkmcnt(0)" ::: "memory");
    const int c = lane & 7;
    const int orow0 = perm ? ((n0 & ~255) + ((n0 >> 5) & 1) * 128 + ((n0 >> 6) & 3) * 32) : n0;
#pragma unroll
    for (int j = 0; j < 4; ++j) { const int n = (lane >> 3) + 8 * j; const LAS float* s = scr + (8 * c) * 33 + n;
        u32x4 o; o.x = cvtpk(s[0 * 33], s[1 * 33]); o.y = cvtpk(s[2 * 33], s[3 * 33]); o.z = cvtpk(s[4 * 33], s[5 * 33]); o.w = cvtpk(s[6 * 33], s[7 * 33]);
        *(u32x4*)(WT + (size_t)(orow0 + n) * K + k0 + 8 * c) = o; }
    asm volatile("s_waitcnt lgkmcnt(0)" ::: "memory");
}
__device__ __forceinline__ int t5_bucket(int n) {
    if (n < 16) return n;
    const int thr[15] = {22, 30, 40, 54, 73, 99, 134, 182, 246, 332, 450, 609, 825, 1117, 1513};
    int b = 16;
#pragma unroll
    for (int k = 0; k < 15; ++k) b += (n >= thr[k]) ? 1 : 0;
    return b;
}

struct Args { const float* in[14]; float* out; unsigned char* ws; int ph_lo, ph_hi, li, pad; };

__global__ void __launch_bounds__(NWAVES * 64, 2) hybrid_fwd(Args args) {
    extern __shared__ __attribute__((aligned(16))) unsigned char lds_raw[];
    LAS unsigned char* lds = (LAS unsigned char*)lds_raw;
    volatile LAS unsigned* MISC = (volatile LAS unsigned*)(lds + MISC_OFF);
    const int tid = threadIdx.x, lane = tid & 63, wave = __builtin_amdgcn_readfirstlane(tid >> 6);
    const int G = gridDim.x, bx = blockIdx.x, vcu = (G % 8 == 0) ? (bx % 8) * (G / 8) + bx / 8 : bx;
    unsigned char* ws = args.ws;
    unsigned* ctl = (unsigned*)(ws + WS_CTL);
    const float* x = args.in[0]; const float* rel_bias = args.in[1]; const float* norm_mix = args.in[2]; const float* norm_ffn = args.in[3];
    const float* a_w_qkv = args.in[4]; const float* a_q_gain = args.in[5]; const float* a_k_gain = args.in[6]; const float* a_w_o = args.in[7];
    const float* b_w_qkv = args.in[8]; const float* b_q_gain = args.in[9]; const float* b_k_gain = args.in[10]; const float* b_w_o = args.in[11];
    const float* ffn_w1 = args.in[12]; const float* ffn_w2 = args.in[13];
    float* out = args.out;
    float* ssp = (float*)(ws + WS_SS); float* kmp = (float*)(ws + WS_KM); float* tblB = (float*)(ws + WS_TBLB); float* tblA = (float*)(ws + WS_TBLA); float* la = (float*)(ws + WS_LA);
    bf16_t* HB = (bf16_t*)(ws + WS_HB); bf16_t* OG = (bf16_t*)(ws + WS_OG); bf16_t* QKV = (bf16_t*)(ws + WS_QKV); bf16_t* O0 = (bf16_t*)(ws + WS_O0); bf16_t* O1 = (bf16_t*)(ws + WS_O1); bf16_t* HH = (bf16_t*)(ws + WS_H);

    for (int u = tid; u < (LDS_BYTES - LDSCTL_OFF) / 4; u += NWAVES * 64) ((LAS unsigned*)(lds + LDSCTL_OFF))[u] = 0u;
    __syncthreads();
    XcdBarrier bar; bar.bar = ctl + CW_BAR; bar.x = 0; bar.st = nullptr;
    if (N_LAUNCHES != PER_PHASE) bar = xcd_barrier_post(ctl + CW_BAR, MISC + 8);
#define GRID_BAR() do { if (N_LAUNCHES != PER_PHASE) xcd_barrier(bar); } while (0)
    const int lo = args.ph_lo, hi = args.ph_hi;
#define IN(k) (lo <= (k) && (k) < hi)
#define BOTH(k) (IN(k) && IN((k) + 1))

    constexpr int I0 = (DM / 64) * (NQKV0 / 32), I1 = (NO0 / 64) * (DM / 32), I2 = (DM / 64) * (NQKV1 / 32), I3 = (NO1 / 64) * (DM / 32), I4 = (DM / 64) * (FF / 32), I5 = (FF / 64) * (DM / 32);
    constexpr int NITEMS_A = I0 + I1, NITEMS = NITEMS_A + I4 + I5 + I2 + I3 + I4 + I5;
#define P0_ITEM(it_) do { int r = (it_); LAS float* scr_ = (LAS float*)(lds + wave * 16384); \
        if (r < I0) { p0_transpose_item(a_w_qkv, DM, NQKV0, (bf16_t*)(ws + W_QKV0), norm_mix, true, scr_, r, lane); break; } r -= I0; \
        if (r < I1) { p0_transpose_item(a_w_o, NO0, DM, (bf16_t*)(ws + W_O0), nullptr, false, scr_, r, lane); break; } r -= I1; \
        if (r < I4) { p0_transpose_item(ffn_w1, DM, FF, (bf16_t*)(ws + W_UP0), norm_ffn, false, scr_, r, lane); break; } r -= I4; \
        if (r < I5) { p0_transpose_item(ffn_w2, FF, DM, (bf16_t*)(ws + W_DN0), nullptr, false, scr_, r, lane); break; } r -= I5; \
        if (r < I2) { p0_transpose_item(b_w_qkv, DM, NQKV1, (bf16_t*)(ws + W_QKV1), norm_mix + DM, true, scr_, r, lane); break; } r -= I2; \
        if (r < I3) { p0_transpose_item(b_w_o, NO1, DM, (bf16_t*)(ws + W_O1), nullptr, false, scr_, r, lane); break; } r -= I3; \
        if (r < I4) { p0_transpose_item(ffn_w1 + (size_t)DM * FF, DM, FF, (bf16_t*)(ws + W_UP1), norm_ffn + DM, false, scr_, r, lane); break; } r -= I4; \
        p0_transpose_item(ffn_w2 + (size_t)FF * DM, FF, DM, (bf16_t*)(ws + W_DN1), nullptr, false, scr_, r, lane); } while (0)
    if (IN(0)) {
        const int gw = vcu * NWAVES + wave, NGW = G * NWAVES;
        for (int it = gw; it < NITEMS_A; it += NGW) P0_ITEM(it);
        for (int m = 2 * gw; m < MTOK; m += 2 * NGW) {
            f32x4 v[2][4]; float s[2] = {0.f, 0.f};
#pragma unroll
            for (int q = 0; q < 2; ++q)
#pragma unroll
                for (int j = 0; j < 2; ++j) { const f32x4* xp = (const f32x4*)(x + (size_t)(m + q) * DM + 512 * j + 8 * lane); v[q][2 * j] = xp[0]; v[q][2 * j + 1] = xp[1]; }
#pragma unroll
            for (int q = 0; q < 2; ++q) {
#pragma unroll
                for (int j = 0; j < 4; ++j) s[q] += (v[q][j][0] * v[q][j][0] + v[q][j][1] * v[q][j][1]) + (v[q][j][2] * v[q][j][2] + v[q][j][3] * v[q][j][3]);
                s[q] = wave_sum(s[q]);
#pragma unroll
                for (int j = 0; j < 2; ++j) { u32x4 w; w.x = cvtpk(v[q][2 * j][0], v[q][2 * j][1]); w.y = cvtpk(v[q][2 * j][2], v[q][2 * j][3]); w.z = cvtpk(v[q][2 * j + 1][0], v[q][2 * j + 1][1]); w.w = cvtpk(v[q][2 * j + 1][2], v[q][2 * j + 1][3]);
                    *(u32x4*)(HB + (size_t)(m + q) * DM + 512 * j + 8 * lane) = w; }
                if (lane == 0) *(f32x4*)(ssp + (size_t)(m + q) * 4) = (f32x4){s[q], 0.f, 0.f, 0.f};
            }
        }
        {
            float mb = 0.f;
            for (int i = lane; i < 32 * 24; i += 64) mb = fmaxf(mb, rel_bias[i]);
            mb = wave_max(mb);
            const float refA = (8.f * wave_max(fabsf(a_q_gain[lane])) * wave_max(fabsf(a_k_gain[lane])) + mb) * LOG2E;
            const float refB = (8.f * wave_max(fabsf(b_q_gain[lane])) * wave_max(fabsf(b_k_gain[lane])) + mb) * LOG2E;
            const int gt = vcu * 512 + tid, NGT = G * 512;
            for (int e = gt; e < 16 * TBLB_N; e += NGT) { const int h = e / TBLB_N, idx = e % TBLB_N, dist = 4095 - idx;
                tblB[e] = (dist < 0) ? NEGV : rel_bias[t5_bucket(dist) * 24 + h] * LOG2E - refB; }
            for (int e = gt; e < 24 * TBLA_N; e += NGT) { const int col = e / TBLA_N, idx = e % TBLA_N, dist = 383 - idx, g = col >> 3;
                tblA[e] = (dist < 0 || dist > 128) ? NEGV : rel_bias[t5_bucket(dist << (2 * g)) * 24 + col] * LOG2E - refA; }
        }
        if (BOTH(0)) GRID_BAR();
    }
    if (IN(1)) {
        pg8::Gemm g{HB, (const bf16_t*)(ws + W_QKV0), MTOK, NQKV0, DM}; pg8::StaticOrder S; S.init(MTOK, NQKV0, G, bx);
        pg8::EpiQKV E{0, ssp, a_q_gain, a_k_gain, QKV, nullptr};
        pg8::gemm_phase<pg8::EpiQKV, pg8::StaticOrder, true, true>(lds, g, S, E);
        {
            const int nun = (MTOK / 256) * (NQKV0 / 256), full = nun % G, nidle = full ? G - full : G;
            if (bx >= full || full == 0) { const int iw = ((full ? bx - full : bx) * NWAVES + wave), NIW = nidle * NWAVES;
                for (int it = NITEMS_A + iw; it < NITEMS; it += NIW) P0_ITEM(it); }
        }
        if (BOTH(1)) GRID_BAR();
    }
    if (IN(2)) {
        const int nit = 768, perw = (nit + G - 1) / G;
        for (int k = 0; k < 3; ++k) {
            int item;
            if (G == 256) item = (k == 0) ? vcu : 256 + 2 * vcu + (k - 1);
            else { item = vcu * perw + k; if (k >= perw || item >= nit) break; }
            int g, sq, i0, R;
            if (item < 128) { g = 0; sq = item >> 2; i0 = (item & 3) * 32; R = 4; }
            else if (item < 256) { g = 1; sq = item - 128; i0 = 0; R = 4; }
            else { g = 2; sq = item - 256; i0 = 0; R = 1; }
            const int sh = 2 * g, dil = 1 << sh, Lg = SEQ >> sh, hh = sq & 7, vb = sq >> 3, b = vb >> sh, c = vb & (dil - 1);
            att::StreamDesc U;
            const size_t seqoff = (size_t)sq * Lg * 64;
            U.Q = QKV + (size_t)(0 * 3 + g) * ((size_t)MTOK * 512) + seqoff; U.K = QKV + (size_t)(1 * 3 + g) * ((size_t)MTOK * 512) + seqoff; U.V = QKV + (size_t)(2 * 3 + g) * ((size_t)MTOK * 512) + seqoff;
            U.i0 = i0; U.R = R; U.tblg = tblA + (size_t)(g * 8 + hh) * TBLA_N;
            U.O = OG + (size_t)g * ((size_t)MTOK * 512) + hh * 64; U.o_row0 = b * SEQ + c; U.o_rstride = dil;
            U.L = la + (size_t)g * ((size_t)MTOK * 8) + hh;
            att::stream(lds, U);
        }
        if (BOTH(2)) GRID_BAR();
    }
    if (IN(3)) {
        const int gt = vcu * 512 + tid, NGT = G * 512;
        for (int e = gt; e < MTOK * 64; e += NGT) {
            const int row = e >> 6, c8 = e & 63, hh = c8 >> 3;
            float acc8[8] = {0.f, 0.f, 0.f, 0.f, 0.f, 0.f, 0.f, 0.f}; float l = 0.f;
#pragma unroll
            for (int g = 0; g < 3; ++g) { const u32x4 w = *(const u32x4*)(OG + (size_t)g * ((size_t)MTOK * 512) + (size_t)row * 512 + c8 * 8);
                l += la[(size_t)g * ((size_t)MTOK * 8) + (size_t)row * 8 + hh];
#pragma unroll
                for (int k = 0; k < 4; ++k) { acc8[2 * k] += __builtin_bit_cast(float, w[k] << 16); acc8[2 * k + 1] += __builtin_bit_cast(float, w[k] & 0xffff0000u); } }
            const float rl = 1.f / l; u32x4 o;
            o.x = cvtpk(acc8[0] * rl, acc8[1] * rl); o.y = cvtpk(acc8[2] * rl, acc8[3] * rl); o.z = cvtpk(acc8[4] * rl, acc8[5] * rl); o.w = cvtpk(acc8[6] * rl, acc8[7] * rl);
            *(u32x4*)(O0 + (size_t)row * 512 + c8 * 8) = o;
        }
        if (BOTH(3)) GRID_BAR();
    }
    if (IN(4)) {
        pg8::Gemm g{O0, (const bf16_t*)(ws + W_O0), MTOK, DM, NO0}; pg8::StaticOrder S; S.init(MTOK, DM, G, bx);
        pg8::EpiRes<0> E{x, out, HB, ssp};
        pg8::gemm_phase<pg8::EpiRes<0>, pg8::StaticOrder, false, true>(lds, g, S, E);
        if (BOTH(4)) GRID_BAR();
    }
#define UP_PHASE(PU, WUP) \
    if (IN(PU)) { pg8::Gemm g{HB, (const bf16_t*)(ws + (WUP)), MTOK, FF, DM}; pg8::StaticOrder S; S.init(MTOK, FF, G, bx); pg8::EpiUp E{ssp, HH}; \
        pg8::gemm_phase<pg8::EpiUp, pg8::StaticOrder, true, true>(lds, g, S, E); if (BOTH(PU)) GRID_BAR(); }
#define DN_PHASE(PD, WDN, MODE) \
    if (IN(PD)) { pg8::Gemm g{HH, (const bf16_t*)(ws + (WDN)), MTOK, DM, FF}; pg8::StaticOrder S; S.init(MTOK, DM, G, bx); pg8::EpiRes<MODE> E{nullptr, out, HB, ssp}; \
        pg8::gemm_phase<pg8::EpiRes<MODE>, pg8::StaticOrder, false, true>(lds, g, S, E); if (BOTH(PD)) GRID_BAR(); }
    UP_PHASE(5, W_UP0)
    DN_PHASE(6, W_DN0, 1)
    if (IN(7)) {
        pg8::Gemm g{HB, (const bf16_t*)(ws + W_QKV1), MTOK, NQKV1, DM}; pg8::StaticOrder S; S.init(MTOK, NQKV1, G, bx);
        pg8::EpiQKV E{1, ssp, b_q_gain, b_k_gain, QKV, kmp};
        pg8::gemm_phase<pg8::EpiQKV, pg8::StaticOrder, true, true>(lds, g, S, E);
        if (BOTH(7)) GRID_BAR();
    }
    if (IN(8)) {
        const int per = (512 + G - 1) / G;
        for (int i = 0; i < per; ++i) {
            int bh, p;
            if (per == 2) { const int s = vcu & 3; bh = vcu >> 2; p = (i == 0) ? s : 7 - s; }
            else { const int uid = vcu * per + i; if (uid >= 512) break; bh = uid >> 3; p = uid & 7; }
            const int b = bh >> 4, h = bh & 15;
            const size_t seqoff = (size_t)bh * SEQ * 64;
            att::moba_pair(lds, p, QKV + seqoff, QKV + (size_t)MTOK * 1024 + seqoff, QKV + (size_t)2 * MTOK * 1024 + seqoff, tblB + (size_t)h * TBLB_N,
                           kmp + (((size_t)0 * BATCH + b) * 16 * 16 + h) * 64, kmp + (((size_t)1 * BATCH + b) * 16 * 16 + h) * 64, O1 + (size_t)(b * SEQ) * 1024 + h * 64);
        }
        if (BOTH(8)) GRID_BAR();
    }
    if (IN(9)) {
        pg8::Gemm g{O1, (const bf16_t*)(ws + W_O1), MTOK, DM, NO1}; pg8::StaticOrder S; S.init(MTOK, DM, G, bx);
        pg8::EpiRes<1> E{nullptr, out, HB, ssp};
        pg8::gemm_phase<pg8::EpiRes<1>, pg8::StaticOrder, false, true>(lds, g, S, E);
        if (BOTH(9)) GRID_BAR();
    }
    UP_PHASE(10, W_UP1)
    DN_PHASE(11, W_DN1, 2)
#undef IN
#undef BOTH
}

extern "C" void kernel_launch(void* const* d_in, const int* in_sizes, int n_in, void* d_out, int out_size, void* d_ws, size_t ws_size, hipStream_t stream) {
    static int grid = 0;
    if (grid == 0) {
        if (n_in != 14 || in_sizes[0] != MTOK * DM || out_size != MTOK * DM || ws_size < WS_END) { fprintf(stderr, "kernel_launch: unexpected shapes (n_in %d, in0 %d, out %d, ws %zu); nothing launched\n", n_in, n_in > 0 ? in_sizes[0] : -1, out_size, ws_size); grid = -1; return; }
        int dev = 0, cus = 0, per_cu = 0;
        if (hipGetDevice(&dev) != hipSuccess || hipDeviceGetAttribute(&cus, hipDeviceAttributeMultiprocessorCount, dev) != hipSuccess) { fprintf(stderr, "kernel_launch: device query failed\n"); grid = -1; return; }
        if (hipFuncSetAttribute((const void*)hybrid_fwd, hipFuncAttributeMaxDynamicSharedMemorySize, LDS_BYTES) != hipSuccess) { fprintf(stderr, "kernel_launch: hipFuncSetAttribute failed\n"); grid = -1; return; }
        if (hipOccupancyMaxActiveBlocksPerMultiprocessor(&per_cu, (const void*)hybrid_fwd, NWAVES * 64, LDS_BYTES) != hipSuccess || per_cu < 1) fprintf(stderr, "kernel_launch: note: occupancy query reports %d workgroups per CU\n", per_cu);
        (void)hipGetLastError();
        grid = cus;
        if (grid != 256) { fprintf(stderr, "kernel_launch: built for a 256-CU device, found %d CUs; nothing launched\n", cus); grid = -1; return; }
    }
    if (grid < 0) return;
    if (hipMemsetAsync((char*)d_ws + WS_CTL, 0, CTL_ZERO_BYTES, stream) != hipSuccess) { fprintf(stderr, "kernel_launch: hipMemsetAsync failed\n"); return; }
    Args a{};
    for (int i = 0; i < 14; ++i) a.in[i] = (const float*)d_in[i];
    a.out = (float*)d_out; a.ws = (unsigned char*)d_ws;
    if (N_LAUNCHES == 1) { a.ph_lo = 0; a.ph_hi = PER_PHASE; a.li = 0; hipLaunchKernelGGL(hybrid_fwd, dim3(grid), dim3(NWAVES * 64), LDS_BYTES, stream, a); }
    else for (int li = 0; li < PER_PHASE; ++li) { a.ph_lo = li; a.ph_hi = li + 1; a.li = li; hipLaunchKernelGGL(hybrid_fwd, dim3(grid), dim3(NWAVES * 64), LDS_BYTES, stream, a); }
    const hipError_t le = hipPeekAtLastError();
    if (le != hipSuccess) fprintf(stderr, "kernel_launch: launch failed: %s\n", hipGetErrorName(le));
}
```

```cpp
#include <hip/hip_runtime.h>
#include <cstdio>
#include <cstdint>

#define LAS __attribute__((address_space(3)))
#define GAS __attribute__((address_space(1)))
typedef unsigned short bf16_t;
typedef short bf16x8 __attribute__((ext_vector_type(8)));
typedef short s16x4 __attribute__((ext_vector_type(4)));
typedef float f32x4 __attribute__((ext_vector_type(4)));
typedef float f32x2 __attribute__((ext_vector_type(2)));
typedef float f32x16 __attribute__((ext_vector_type(16)));
typedef unsigned u32x4 __attribute__((ext_vector_type(4)));
typedef unsigned u32x2 __attribute__((ext_vector_type(2)));
typedef __bf16 bf16x2_t __attribute__((ext_vector_type(2)));

constexpr int BATCH = 4, SEQ = 4096, DM = 1024, MTOK = BATCH * SEQ, FF = 4096, HD = 64;
constexpr int NQKV0 = 4608, NO0 = 512, NQKV1 = 3072, NO1 = 1024;
constexpr float EPS = 1e-6f, LOG2E = 1.4426950408889634f, QSCALE = 0.125f * LOG2E, NEGV = -1e30f;
constexpr int TBLB_N = 4352, TBLA_N = 640, TOFF = 255;

__device__ __forceinline__ unsigned cvtpk(float lo, float hi) { f32x2 v = {lo, hi}; bf16x2_t b = __builtin_convertvector(v, bf16x2_t); return __builtin_bit_cast(unsigned, b); }
__device__ __forceinline__ float bf2f(unsigned short h) { return __builtin_bit_cast(float, (unsigned)h << 16); }
__device__ __forceinline__ float rsq(float x) { return __builtin_amdgcn_rsqf(x); }

namespace pg8 {
constexpr int BM = 256, BK = 64, HALF = 128, HTB = HALF * BK * 2, STAGE_BYTES = 8 * HTB, NXCD = 8, WGM = 4;
__host__ __device__ __forceinline__ int lds_byte(int r, int c) { const int st = (r >> 4) * 2 + (c >> 5), rr = r & 15, cc = c & 31, ob = rr * 64 + cc * 2; return st * 1024 + (ob ^ (((ob >> 9) & 1) << 5)); }
__host__ __device__ __forceinline__ void stage_rc(int b, int& R, int& C) { const int st = b / 1024, sb = b % 1024, swz = sb ^ (((sb >> 9) & 1) << 5); R = (st >> 1) * 16 + swz / 64; C = (st & 1) * 32 + (swz % 64) / 2; }
__host__ __device__ __forceinline__ int perm32(int rho) { const int n = rho >> 4, i = rho & 15; return 8 * (i >> 2) + 4 * n + (i & 3); }
struct Unit { int pm, pn; };
struct Gemm { const bf16_t* A; const bf16_t* Bt; int M, N, K; };
struct StaticOrder {
    int nM, nN, nwg, G, c;
    __host__ __device__ void init(int M, int N, int G_, int c_) { nM = M / BM; nN = N / BM; nwg = nM * nN; G = G_; c = c_; }
    __host__ __device__ bool next(int i, Unit& u) const {
        const long L = (long)i * G + c; if (L >= nwg) return false;
        int wgid = (int)L; { const int q = nwg / NXCD, r = nwg % NXCD, xcd = wgid % NXCD, off = wgid / NXCD; wgid = (xcd < r ? xcd * (q + 1) : r * (q + 1) + (xcd - r) * q) + off; }
        const int nig = WGM * nN, gid = wgid / nig, fm = gid * WGM, gsz = (nM - fm) < WGM ? (nM - fm) : WGM;
        u.pm = fm + ((wgid % nig) % gsz); u.pn = (wgid % nig) / gsz; return true;
    }
};

struct EpiQKV {
    static constexpr bool PERM = true, AFTER_DRAIN = false;
    int layer; const float* ssp; const float* gq; const float* gk; bf16_t* dst; float* kmp;
    __device__ __forceinline__ void operator()(const f32x4 (&acc)[2][2][4][2], const Unit& u, int wr, int wc, int fr, int fq) const {
        const int pn = u.pn, pm = u.pm; int kind, hh, g = 0;
        if (layer == 0) { kind = pn / 6; const int rem = pn % 6; g = rem >> 1; hh = (rem & 1) * 4 + wc; } else { kind = pn >> 2; hh = (pn & 3) * 4 + wc; }
        f32x4 gv[2][2]; const float* gp = (kind == 0) ? gq : gk;
#pragma unroll
        for (int bj = 0; bj < 2; ++bj)
#pragma unroll
            for (int n = 0; n < 2; ++n) gv[bj][n] = *(const f32x4*)(gp + 32 * bj + 8 * fq + 4 * n);
        f32x4 cs[2][2];
#pragma unroll
        for (int bj = 0; bj < 2; ++bj)
#pragma unroll
            for (int n = 0; n < 2; ++n) cs[bj][n] = (f32x4){0.f, 0.f, 0.f, 0.f};
        const bool km = (layer == 1 && kind == 1);
#pragma unroll
        for (int ai = 0; ai < 2; ++ai)
#pragma unroll
            for (int m = 0; m < 4; ++m) {
                const int row = pm * BM + ai * HALF + wr * 64 + m * 16 + fr;
                const f32x4 pv = *(const f32x4*)(ssp + (size_t)row * 4);
                const float r = rsq(((pv[0] + pv[1]) + (pv[2] + pv[3])) * (1.f / 1024.f) + EPS);
                f32x4 v[2][2];
#pragma unroll
                for (int bj = 0; bj < 2; ++bj)
#pragma unroll
                    for (int n = 0; n < 2; ++n) v[bj][n] = acc[ai][bj][m][n] * r;
                if (kind < 2) {
                    float s = 0.f;
#pragma unroll
                    for (int bj = 0; bj < 2; ++bj)
#pragma unroll
                        for (int n = 0; n < 2; ++n) { const f32x4 x = v[bj][n]; s += (x[0] * x[0] + x[1] * x[1]) + (x[2] * x[2] + x[3] * x[3]); }
                    s += __shfl_xor(s, 16); s += __shfl_xor(s, 32);
                    float rn = rsq(s * (1.f / 64.f) + EPS); if (kind == 0) rn *= QSCALE;
#pragma unroll
                    for (int bj = 0; bj < 2; ++bj)
#pragma unroll
                        for (int n = 0; n < 2; ++n) { v[bj][n] = v[bj][n] * rn * gv[bj][n]; if (km) cs[bj][n] += v[bj][n]; }
                }
                const int b = row >> 12, t = row & 4095; size_t off;
                if (layer == 0) { const int sh = 2 * g, c = t & ((1 << sh) - 1), l = t >> sh;
                    off = (size_t)(kind * 3 + g) * ((size_t)MTOK * 512) + ((((size_t)((b << sh) + c)) * 8 + hh) * (size_t)(4096 >> sh) + l) * 64; }
                else off = (size_t)kind * ((size_t)MTOK * 1024) + (((size_t)b * 16 + hh) * 4096 + t) * 64;
                bf16_t* p = dst + off + 8 * fq;
#pragma unroll
                for (int bj = 0; bj < 2; ++bj) { u32x4 w; w.x = cvtpk(v[bj][0][0], v[bj][0][1]); w.y = cvtpk(v[bj][0][2], v[bj][0][3]); w.z = cvtpk(v[bj][1][0], v[bj][1][1]); w.w = cvtpk(v[bj][1][2], v[bj][1][3]);
                    *(u32x4*)(p + 32 * bj) = w; }
            }
        if (km) {
#pragma unroll
            for (int bj = 0; bj < 2; ++bj)
#pragma unroll
                for (int n = 0; n < 2; ++n)
#pragma unroll
                    for (int e = 0; e < 4; ++e) { float x = cs[bj][n][e]; x += __shfl_xor(x, 1); x += __shfl_xor(x, 2); x += __shfl_xor(x, 4); x += __shfl_xor(x, 8); cs[bj][n][e] = x; }
            if (fr == 0) { const int b = pm >> 4, nb = pm & 15; float* kp = kmp + ((((size_t)wr * BATCH + b) * 16 + nb) * 16 + hh) * 64 + 8 * fq;
#pragma unroll
                for (int bj = 0; bj < 2; ++bj)
#pragma unroll
                    for (int n = 0; n < 2; ++n) *(f32x4*)(kp + 32 * bj + 4 * n) = cs[bj][n]; }
        }
    }
};
struct EpiUp {
    static constexpr bool PERM = true, AFTER_DRAIN = false;
    const float* ssp; bf16_t* H;
    __device__ __forceinline__ void operator()(const f32x4 (&acc)[2][2][4][2], const Unit& u, int wr, int wc, int fr, int fq) const {
#pragma unroll
        for (int ai = 0; ai < 2; ++ai)
#pragma unroll
            for (int m = 0; m < 4; ++m) {
                const int row = u.pm * BM + ai * HALF + wr * 64 + m * 16 + fr;
                const f32x4 pv = *(const f32x4*)(ssp + (size_t)row * 4);
                const float r = rsq(((pv[0] + pv[1]) + (pv[2] + pv[3])) * (1.f / 1024.f) + EPS);
                bf16_t* rowp = H + (size_t)row * FF + u.pn * BM + wc * 32 + 8 * fq;
#pragma unroll
                for (int bj = 0; bj < 2; ++bj) { f32x4 v0 = acc[ai][bj][m][0] * r, v1 = acc[ai][bj][m][1] * r;
#pragma unroll
                    for (int e = 0; e < 4; ++e) { const float a = fmaxf(v0[e], 0.f), b = fmaxf(v1[e], 0.f); v0[e] = a * a; v1[e] = b * b; }
                    u32x4 w; w.x = cvtpk(v0[0], v0[1]); w.y = cvtpk(v0[2], v0[3]); w.z = cvtpk(v1[0], v1[1]); w.w = cvtpk(v1[2], v1[3]);
                    *(u32x4*)(rowp + bj * HALF) = w; }
            }
    }
};
template <int MODE> struct EpiRes {
    static constexpr bool PERM = true, AFTER_DRAIN = true;
    const float* basef; float* out; bf16_t* hb; float* ssp;
    __device__ __forceinline__ void fused(f32x4 (&acc)[2][2][4][2], const Unit& u, int wr, int wc, int fr, int fq, LAS unsigned char* lds, int wid, int lane) const {
        LAS float* P = (LAS float*)lds;
        const int col0 = u.pn * BM + wc * 32 + 8 * fq;
#pragma unroll
        for (int ai = 0; ai < 2; ++ai)
#pragma unroll
            for (int m = 0; m < 4; ++m) {
                const int rl = ai * HALF + wr * 64 + m * 16 + fr; const size_t off = (size_t)(u.pm * BM + rl) * DM + col0; float s = 0.f;
                f32x4 bv[2][2];
#pragma unroll
                for (int bj = 0; bj < 2; ++bj) {
                    if (MODE == 0) { bv[bj][0] = *(const f32x4*)(basef + off + bj * HALF); bv[bj][1] = *(const f32x4*)(basef + off + bj * HALF + 4); }
                    else { const u32x4 w = *(const u32x4*)(hb + off + bj * HALF);
                        bv[bj][0] = (f32x4){__builtin_bit_cast(float, w.x << 16), __builtin_bit_cast(float, w.x & 0xffff0000u), __builtin_bit_cast(float, w.y << 16), __builtin_bit_cast(float, w.y & 0xffff0000u)};
                        bv[bj][1] = (f32x4){__builtin_bit_cast(float, w.z << 16), __builtin_bit_cast(float, w.z & 0xffff0000u), __builtin_bit_cast(float, w.w << 16), __builtin_bit_cast(float, w.w & 0xffff0000u)}; } }
#pragma unroll
                for (int bj = 0; bj < 2; ++bj) { const f32x4 h0 = bv[bj][0] + acc[ai][bj][m][0], h1 = bv[bj][1] + acc[ai][bj][m][1];
                    if (MODE == 2) { *(f32x4*)(out + off + bj * HALF) = h0; *(f32x4*)(out + off + bj * HALF + 4) = h1; }
                    else { u32x4 w; w.x = cvtpk(h0[0], h0[1]); w.y = cvtpk(h0[2], h0[3]); w.z = cvtpk(h1[0], h1[1]); w.w = cvtpk(h1[2], h1[3]); *(u32x4*)(hb + off + bj * HALF) = w;
                        s += ((h0[0] * h0[0] + h0[1] * h0[1]) + (h0[2] * h0[2] + h0[3] * h0[3])) + ((h1[0] * h1[0] + h1[1] * h1[1]) + (h1[2] * h1[2] + h1[3] * h1[3])); } }
                if (MODE != 2) { s += __shfl_xor(s, 16); s += __shfl_xor(s, 32); if (fq == 0) P[rl * 4 + wc] = s; }
                asm volatile("" ::: "memory");
            }
        if (MODE != 2) {
            asm volatile("s_waitcnt lgkmcnt(0)" ::: "memory"); __builtin_amdgcn_s_barrier(); asm volatile("" ::: "memory");
            const int t = wid * 64 + lane;
            if (t < 256) { const f32x4 p = *(const LAS f32x4*)(P + t * 4); ssp[(size_t)(u.pm * BM + t) * 4 + u.pn] = (p[0] + p[1]) + (p[2] + p[3]); }
        }
    }
};

template <class Epi, class Sched, bool ALIGN_EPI = false, bool SP2 = false>
__device__ __forceinline__ void gemm_phase(LAS unsigned char* lds, const Gemm g, const Sched& S, const Epi& E) {
    const int tid = threadIdx.x, wid = __builtin_amdgcn_readfirstlane(tid >> 6), lane = tid & 63, wr = wid >> 2, wc = wid & 3, fr = lane & 15, fq = lane >> 4;
    const int K = g.K, nt = K / BK;
    unsigned voffA[2], voffB[2];
#pragma unroll
    for (int i = 0; i < 2; ++i) { int R, C; stage_rc(tid * 16 + i * 8192, R, C); const int Rb = Epi::PERM ? ((R & ~31) + perm32(R & 31)) : R;
        voffA[i] = (unsigned)(R * K + C) * 2u; voffB[i] = (unsigned)(Rb * K + C) * 2u; }
    const size_t kstep = (size_t)(BK * 2);
    const size_t hstep = (size_t)HALF * K * 2;
    const size_t tstep = 2 * hstep;
    const unsigned ldsw = (unsigned)wid * 1024u;
    const int aoff = lds_byte(wr * 64 + fr, fq * 8), boff = lds_byte(wc * 32 + fr, fq * 8);
#define PG8_SA(b, h) (((b) * 2 + (h)) * HTB)
#define PG8_SB(b, h) ((4 + (b) * 2 + (h)) * HTB)
#define PG8_STAGE(bufoff, gbase, voff) do { _Pragma("unroll") for (int _i = 0; _i < 2; ++_i) \
        __builtin_amdgcn_global_load_lds((const unsigned*)((const char*)(gbase) + (voff)[_i]), (LAS unsigned*)(lds + (bufoff) + ldsw + _i * 8192), 16, 0, 0); } while (0)
#define PG8_LDA(dst, b, h) do { _Pragma("unroll") for (int m = 0; m < 4; ++m) _Pragma("unroll") for (int k = 0; k < 2; ++k) dst[m][k] = *(const LAS bf16x8*)(lds + PG8_SA(b, h) + aoff + m * 2048 + k * 1024); } while (0)
#define PG8_LDB(dst, b, h) do { _Pragma("unroll") for (int n = 0; n < 2; ++n) _Pragma("unroll") for (int k = 0; k < 2; ++k) dst[n][k] = *(const LAS bf16x8*)(lds + PG8_SB(b, h) + boff + n * 2048 + k * 1024); } while (0)
#define PG8_MMA(ai, bj, At, Bt) do { __builtin_amdgcn_s_setprio(1); _Pragma("unroll") for (int m = 0; m < 4; ++m) _Pragma("unroll") for (int n = 0; n < 2; ++n) _Pragma("unroll") for (int k = 0; k < 2; ++k) \
        acc[ai][bj][m][n] = __builtin_amdgcn_mfma_f32_16x16x32_bf16(Bt[n][k], At[m][k], acc[ai][bj][m][n], 0, 0, 0); __builtin_amdgcn_s_setprio(0); } while (0)
#define PG8_WAIT_V(n) asm volatile("s_waitcnt vmcnt(" #n ")" ::: "memory")
#define PG8_WAIT_L(n) asm volatile("s_waitcnt lgkmcnt(" #n ")" ::: "memory")
#define PG8_BAR __builtin_amdgcn_s_barrier()
#define PG8_SCHED __builtin_amdgcn_sched_barrier(0)
    Unit cur, nxt; int ui = 0;
    if (!S.next(0, cur)) return;
    f32x4 acc[2][2][4][2];
#pragma unroll
    for (int a = 0; a < 2; ++a)
#pragma unroll
        for (int b = 0; b < 2; ++b)
#pragma unroll
            for (int m = 0; m < 4; ++m)
#pragma unroll
                for (int n = 0; n < 2; ++n) acc[a][b][m][n] = (f32x4){0.f, 0.f, 0.f, 0.f};
    bf16x8 At[4][2], B0[2][2], B1[2][2];
    const char* cA = (const char*)g.A + (size_t)cur.pm * tstep; const char* cB = (const char*)g.Bt + (size_t)cur.pn * tstep;
    if constexpr (SP2) {
        PG8_STAGE(PG8_SB(0, 0), cB, voffB); PG8_STAGE(PG8_SB(0, 1), cB + hstep, voffB); PG8_STAGE(PG8_SA(0, 0), cA, voffA); PG8_STAGE(PG8_SA(0, 1), cA + hstep, voffA);
        if (wr == 1) PG8_BAR;
        PG8_WAIT_V(2); PG8_BAR;
        PG8_STAGE(PG8_SB(1, 0), cB + kstep, voffB); PG8_STAGE(PG8_SA(1, 0), cA + kstep, voffA); PG8_STAGE(PG8_SB(1, 1), cB + hstep + kstep, voffB);
        PG8_WAIT_V(6); PG8_BAR;
    } else {
        PG8_STAGE(PG8_SB(0, 0), cB, voffB); PG8_STAGE(PG8_SA(0, 0), cA, voffA); PG8_STAGE(PG8_SB(0, 1), cB + hstep, voffB); PG8_STAGE(PG8_SA(0, 1), cA + hstep, voffA);
        if (wr == 1) PG8_BAR;
        PG8_WAIT_V(4); PG8_BAR;
        PG8_STAGE(PG8_SB(1, 0), cB + kstep, voffB); PG8_STAGE(PG8_SA(1, 0), cA + kstep, voffA); PG8_STAGE(PG8_SB(1, 1), cB + hstep + kstep, voffB);
        PG8_WAIT_V(6); PG8_BAR;
    }
    for (;;) {
        const bool has_next = S.next(ui + 1, nxt);
        const char* nA = has_next ? (const char*)g.A + (size_t)nxt.pm * tstep : cA; const char* nB = has_next ? (const char*)g.Bt + (size_t)nxt.pn * tstep : cB;
        for (int t = 0; t < nt; t += 2) {
            const bool last = (t == nt - 2);
            const char* a1 = cA + (size_t)(t + 1) * kstep;
            const char* a2 = last ? nA : cA + (size_t)(t + 2) * kstep; const char* b2 = last ? nB : cB + (size_t)(t + 2) * kstep;
            const char* a3 = a2 + kstep; const char* b3 = b2 + kstep;
            if constexpr (SP2) {
            PG8_LDB(B0, 0, 0); PG8_LDB(B1, 0, 1); PG8_SCHED; PG8_LDA(At, 0, 0); PG8_STAGE(PG8_SA(1, 1), a1 + hstep, voffA);
            PG8_WAIT_V(8); PG8_WAIT_L(0); PG8_BAR; PG8_MMA(0, 0, At, B0); PG8_MMA(0, 1, At, B1); PG8_BAR; PG8_SCHED;
            PG8_LDA(At, 0, 1); PG8_STAGE(PG8_SB(0, 0), b2, voffB); PG8_STAGE(PG8_SB(0, 1), b2 + hstep, voffB); PG8_STAGE(PG8_SA(0, 0), a2, voffA);
            PG8_WAIT_V(8); PG8_WAIT_L(0); PG8_BAR; PG8_MMA(1, 0, At, B0); PG8_MMA(1, 1, At, B1); PG8_BAR; PG8_SCHED;
            PG8_LDB(B0, 1, 0); PG8_LDB(B1, 1, 1); PG8_SCHED; PG8_LDA(At, 1, 0); PG8_STAGE(PG8_SA(0, 1), a2 + hstep, voffA);
            PG8_WAIT_V(8); PG8_WAIT_L(0); PG8_BAR; PG8_MMA(0, 0, At, B0); PG8_MMA(0, 1, At, B1); PG8_BAR; PG8_SCHED;
            PG8_LDA(At, 1, 1); PG8_STAGE(PG8_SB(1, 0), b3, voffB); PG8_STAGE(PG8_SB(1, 1), b3 + hstep, voffB); PG8_STAGE(PG8_SA(1, 0), a3, voffA);
            PG8_WAIT_V(8); PG8_WAIT_L(0); PG8_BAR; PG8_MMA(1, 0, At, B0); PG8_MMA(1, 1, At, B1); PG8_BAR; PG8_SCHED;
            } else {
            PG8_LDB(B0, 0, 0); PG8_SCHED; PG8_LDA(At, 0, 0); PG8_STAGE(PG8_SA(1, 1), a1 + hstep, voffA);
            PG8_WAIT_L(8); PG8_BAR; PG8_WAIT_L(0); PG8_MMA(0, 0, At, B0); PG8_BAR; PG8_SCHED;
            PG8_LDB(B1, 0, 1); PG8_STAGE(PG8_SB(0, 0), b2, voffB);
            PG8_BAR; PG8_WAIT_L(0); PG8_MMA(0, 1, At, B1); PG8_BAR;
            PG8_LDA(At, 0, 1); PG8_STAGE(PG8_SA(0, 0), a2, voffA);
            PG8_BAR; PG8_WAIT_L(0); PG8_MMA(1, 0, At, B0); PG8_BAR; PG8_SCHED;
            PG8_STAGE(PG8_SB(0, 1), b2 + hstep, voffB);
            PG8_WAIT_V(6); PG8_BAR; PG8_MMA(1, 1, At, B1); PG8_BAR;
            PG8_LDB(B0, 1, 0); PG8_SCHED; PG8_LDA(At, 1, 0); PG8_STAGE(PG8_SA(0, 1), a2 + hstep, voffA);
            PG8_WAIT_L(8); PG8_BAR; PG8_WAIT_L(0); PG8_MMA(0, 0, At, B0); PG8_BAR; PG8_SCHED;
            PG8_LDB(B1, 1, 1); PG8_STAGE(PG8_SB(1, 0), b3, voffB);
            PG8_BAR; PG8_WAIT_L(0); PG8_MMA(0, 1, At, B1); PG8_BAR;
            PG8_LDA(At, 1, 1); PG8_STAGE(PG8_SA(1, 0), a3, voffA);
            PG8_BAR; PG8_WAIT_L(0); PG8_MMA(1, 0, At, B0); PG8_BAR; PG8_SCHED;
            PG8_STAGE(PG8_SB(1, 1), b3 + hstep, voffB);
            PG8_WAIT_V(6); PG8_BAR; PG8_MMA(1, 1, At, B1); PG8_BAR;
            }
        }
        if constexpr (ALIGN_EPI) { if (wr == 0) PG8_BAR; }
        if constexpr (!Epi::AFTER_DRAIN) { E(acc, cur, wr, wc, fr, fq); }
        if (!has_next) break;
#pragma unroll
        for (int a = 0; a < 2; ++a)
#pragma unroll
            for (int b = 0; b < 2; ++b)
#pragma unroll
                for (int m = 0; m < 4; ++m)
#pragma unroll
                    for (int n = 0; n < 2; ++n) acc[a][b][m][n] = (f32x4){0.f, 0.f, 0.f, 0.f};
        cur = nxt; cA = nA; cB = nB; ++ui;
        if constexpr (ALIGN_EPI) { if (wr == 1) PG8_BAR; }
    }
    PG8_WAIT_V(0);
    if constexpr (!ALIGN_EPI) { if (wr == 0) PG8_BAR; }
    PG8_BAR;
    if constexpr (Epi::AFTER_DRAIN) { E.fused(acc, cur, wr, wc, fr, fq, lds, wid, lane); }
#undef PG8_SA
#undef PG8_SB
#undef PG8_STAGE
#undef PG8_LDA
#undef PG8_LDB
#undef PG8_MMA
#undef PG8_WAIT_V
#undef PG8_WAIT_L
#undef PG8_BAR
#undef PG8_SCHED
}
}

namespace att {
constexpr int KB_OFF = 0, VB_OFF = 32768, TBL_OFF = 65536, OST_OFF = 68608, WS_OFF = OST_OFF + 8 * 4096, LDS_END = WS_OFF + 8 * 128;
__device__ __forceinline__ int crow(int r, int hi) { return (r & 3) + 8 * (r >> 2) + 4 * hi; }
#define ATT_WAIT_BAR() asm volatile("s_waitcnt vmcnt(0) lgkmcnt(0)\n\ts_barrier" ::: "memory")
__device__ __forceinline__ void glds16(const void* gsrc, unsigned lds_dst) { unsigned keep;
    asm volatile("s_mov_b32 %0, m0\n\ts_mov_b32 m0, %2\n\ts_nop 0\n\tglobal_load_lds_dwordx4 %1, off\n\ts_mov_b32 m0, %0" : "=&s"(keep) : "v"(gsrc), "s"(lds_dst) : "memory"); }

struct StreamDesc {
    const bf16_t* Q; const bf16_t* K; const bf16_t* V;
    int i0, R;
    const float* tblg;
    bf16_t* O; int o_row0, o_rstride;
    float* L;
};
constexpr int S_KB = 0, S_VB = 49152, S_TBL = 98304, S_OST = 101376, S_WS = S_OST + 8 * 4096, S_END = S_WS + 8 * 128;
__device__ __forceinline__ void stream(LAS unsigned char* lds, const StreamDesc& U) {
    const int tid = threadIdx.x, lane = tid & 63, r32 = lane & 31, hi = lane >> 5; const int wid = __builtin_amdgcn_readfirstlane(tid >> 6);
    LAS float* tbl = (LAS float*)(lds + S_TBL);
    { int t_ = tid; asm volatile("" : "+v"(t_));
      for (int i = t_; i < TBLA_N / 4; i += 512) ((LAS f32x4*)tbl)[i] = ((const f32x4*)U.tblg)[i]; }
    const unsigned lds0 = (unsigned)(uintptr_t)lds;
#define ATT_DMA(t) do { int l_ = lane; asm volatile("" : "+v"(l_)); const int sl_ = (t) % 6; \
        glds16(U.K + (size_t)l_ * 64 + wid * 8 + (size_t)(t) * 4096, (unsigned)__builtin_amdgcn_readfirstlane((int)(lds0 + S_KB + sl_ * 8192 + wid * 1024))); \
        glds16(U.V + (size_t)(16 * (wid & 3) + (l_ >> 2)) * 64 + (wid >> 2) * 32 + (l_ & 3) * 8 + (size_t)(t) * 4096, (unsigned)__builtin_amdgcn_readfirstlane((int)(lds0 + S_VB + sl_ * 8192 + wid * 1024))); } while (0)
    const int t_first = (U.i0 >> 1) - 2 > 0 ? (U.i0 >> 1) - 2 : 0, t_last = (U.i0 >> 1) + 4 * U.R - 1;
    int r = 0;
    int qt = U.i0 + wid;
    bf16x8 qr[4], qn[4];
#pragma unroll
    for (int d0 = 0; d0 < 4; ++d0) { qr[d0] = *(const bf16x8*)(U.Q + (size_t)(qt * 32 + r32) * 64 + d0 * 16 + hi * 8);
        qn[d0] = *(const bf16x8*)(U.Q + (size_t)((U.R > 1 ? qt + 8 : qt) * 32 + r32) * 64 + d0 * 16 + hi * 8); }
    ATT_DMA(t_first); ATT_DMA(t_first + 1);
    f32x16 o[2], ol; o[0] = (f32x16){0.f, 0.f, 0.f, 0.f, 0.f, 0.f, 0.f, 0.f, 0.f, 0.f, 0.f, 0.f, 0.f, 0.f, 0.f, 0.f}; o[1] = o[0]; ol = o[0];
    const int vb0 = (int)(unsigned)(uintptr_t)(lds + S_VB) + ((lane >> 4) & 1) * 32 + (lane & 3) * 8 + (4 * hi + ((lane & 15) >> 2)) * 64;
    const bf16x8 ones = {0x3F80, 0x3F80, 0x3F80, 0x3F80, 0x3F80, 0x3F80, 0x3F80, 0x3F80};
    LAS bf16_t* stg = (LAS bf16_t*)(lds + S_OST) + wid * 2048;
    LAS float* wsl = (LAS float*)(lds + S_WS) + wid * 32;
    ATT_WAIT_BAR();
#define ST_TILEH(tt, H0, H1) do { const int kbase_ = (tt) * 64, qrow_ = qt * 32 + r32, sl_ = (tt) % 6; \
        const LAS float* tp_ = tbl + (383 - (qrow_ - kbase_) + 4 * hi); f32x16 p0, p1; \
        _Pragma("unroll") for (int rr = 0; rr < 16; ++rr) { const int cc = (rr & 3) + 8 * (rr >> 2); if (H0) p0[rr] = tp_[cc]; if (H1) p1[rr] = tp_[cc + 32]; } \
        const LAS unsigned char* kb_ = lds + S_KB + sl_ * 8192 + hi * 1024 + r32 * 16; \
        _Pragma("unroll") for (int d0 = 0; d0 < 4; ++d0) { \
            if (H0) { const bf16x8 kf0_ = *(const LAS bf16x8*)(kb_ + d0 * 2048); p0 = __builtin_amdgcn_mfma_f32_32x32x16_bf16(kf0_, qr[d0], p0, 0, 0, 0); } \
            if (H1) { const bf16x8 kf1_ = *(const LAS bf16x8*)(kb_ + d0 * 2048 + 512); p1 = __builtin_amdgcn_mfma_f32_32x32x16_bf16(kf1_, qr[d0], p1, 0, 0, 0); } } \
        _Pragma("unroll") for (int rr = 0; rr < 16; ++rr) { if (H0) p0[rr] = __builtin_amdgcn_exp2f(p0[rr]); if (H1) p1[rr] = __builtin_amdgcn_exp2f(p1[rr]); } \
        u32x4 pw[4]; \
        _Pragma("unroll") for (int k = 0; k < 2; ++k) { \
            if (H0) pw[k] = (u32x4){cvtpk(p0[8 * k], p0[8 * k + 1]), cvtpk(p0[8 * k + 2], p0[8 * k + 3]), cvtpk(p0[8 * k + 4], p0[8 * k + 5]), cvtpk(p0[8 * k + 6], p0[8 * k + 7])}; \
            if (H1) pw[2 + k] = (u32x4){cvtpk(p1[8 * k], p1[8 * k + 1]), cvtpk(p1[8 * k + 2], p1[8 * k + 3]), cvtpk(p1[8 * k + 4], p1[8 * k + 5]), cvtpk(p1[8 * k + 6], p1[8 * k + 7])}; } \
        _Pragma("unroll") for (int ks = (H0) ? 0 : 2; ks < ((H1) ? 4 : 2); ++ks) ol = __builtin_amdgcn_mfma_f32_32x32x16_bf16(__builtin_bit_cast(bf16x8, pw[ks]), ones, ol, 0, 0, 0); \
        const int vb_ = vb0 + sl_ * 8192; \
        _Pragma("unroll") for (int d0 = 0; d0 < 2; ++d0) { s16x4 vlo[4], vhi[4]; \
            _Pragma("unroll") for (int ks = (H0) ? 0 : 2; ks < ((H1) ? 4 : 2); ++ks) { vlo[ks] = __builtin_bit_cast(s16x4, __builtin_amdgcn_ds_read_tr16_b64_v4i16((LAS s16x4*)(uintptr_t)(unsigned)(vb_ + d0 * 4096 + ks * 1024))); \
                                                             vhi[ks] = __builtin_bit_cast(s16x4, __builtin_amdgcn_ds_read_tr16_b64_v4i16((LAS s16x4*)(uintptr_t)(unsigned)(vb_ + d0 * 4096 + ks * 1024 + 512))); } \
            _Pragma("unroll") for (int ks = (H0) ? 0 : 2; ks < ((H1) ? 4 : 2); ++ks) { const bf16x8 vf = (bf16x8){vlo[ks][0], vlo[ks][1], vlo[ks][2], vlo[ks][3], vhi[ks][0], vhi[ks][1], vhi[ks][2], vhi[ks][3]}; \
                o[d0] = __builtin_amdgcn_mfma_f32_32x32x16_bf16(__builtin_bit_cast(bf16x8, pw[ks]), vf, o[d0], 0, 0, 0); } } } while (0)
#define ST_TILE(tt) ST_TILEH(tt, true, true)
    int pend_qt = -1;
#define ST_FLUSH() do { if (pend_qt >= 0) { \
        { const float lv = wsl[r32]; float* lp = U.L + (size_t)(U.o_row0 + (pend_qt * 32 + r32) * U.o_rstride) * 8; if (hi == 0) *lp = lv; } \
        _Pragma("unroll") for (int i = 0; i < 4; ++i) { const int row = i * 8 + (lane >> 3), ch = lane & 7; const u32x4 v = *(const LAS u32x4*)(stg + row * 64 + ch * 8); \
            *(u32x4*)(U.O + (size_t)(U.o_row0 + (pend_qt * 32 + row) * U.o_rstride) * 512 + ch * 8) = v; } \
        if (r + 1 < U.R) { _Pragma("unroll") for (int d0 = 0; d0 < 4; ++d0) qn[d0] = *(const bf16x8*)(U.Q + (size_t)((qt + 8) * 32 + r32) * 64 + d0 * 16 + hi * 8); } \
        pend_qt = -1; } } while (0)
    for (int t = t_first; t < t_last; t += 2) {
        if (t + 2 < t_last) { ATT_DMA(t + 2); ATT_DMA(t + 3); }
        ST_FLUSH();
        if (r < U.R) {
            const int wend = qt >> 1;
            const bool a0 = (t >= wend - 2) && (t <= wend), a1 = (t + 1 >= wend - 2) && (t + 1 <= wend);
            const bool odd = qt & 1;
            if (a0 && a1) {
                if (t == wend - 2) { if (odd) ST_TILEH(t, false, true); else ST_TILE(t); ST_TILE(t + 1); }
                else { ST_TILE(t); if (!odd) ST_TILEH(t + 1, true, false); else ST_TILE(t + 1); } }
            else if (a0) { if (!odd && t == wend) ST_TILEH(t, true, false); else ST_TILE(t); }
            else if (a1) { if (odd && t + 1 == wend - 2) ST_TILEH(t + 1, false, true); else ST_TILE(t + 1); }
            if (wend == t || wend == t + 1) {
#pragma unroll
                for (int rr = 0; rr < 16; ++rr) { const int orow = crow(rr, hi);
#pragma unroll
                    for (int d0 = 0; d0 < 2; ++d0) stg[orow * 64 + d0 * 32 + r32] = (bf16_t)(cvtpk(o[d0][rr], 0.f) & 0xffffu);
                    if (r32 == 0) wsl[orow] = ol[rr]; }
                pend_qt = qt; ++r; qt += 8;
                o[0] = (f32x16){0.f, 0.f, 0.f, 0.f, 0.f, 0.f, 0.f, 0.f, 0.f, 0.f, 0.f, 0.f, 0.f, 0.f, 0.f, 0.f}; o[1] = o[0]; ol = o[0];
#pragma unroll
                for (int d0 = 0; d0 < 4; ++d0) qr[d0] = qn[d0];
            }
        }
        ATT_WAIT_BAR();
    }
    ST_FLUSH();
    asm volatile("s_waitcnt vmcnt(0)" ::: "memory");
#undef ST_FLUSH
#undef ATT_DMA
#undef ST_TILE
#undef ST_TILEH
}

constexpr int D_KB = 0, D_VB = 32768, D_TBL = 65536, D_KM = 82944, D_OST = 91136, D_END = D_OST + 8 * 4096;
__device__ __forceinline__ void moba_pair(LAS unsigned char* lds, int p, const bf16_t* Qs, const bf16_t* Ks, const bf16_t* Vs, const float* tblg, const float* kmp0, const float* kmp1, bf16_t* O) {
    const int tid = threadIdx.x, lane = tid & 63, r32 = lane & 31, hi = lane >> 5; const int wid = __builtin_amdgcn_readfirstlane(tid >> 6);
    LAS float* tbl = (LAS float*)(lds + D_TBL);
    const int qbA = 2 * p, qbB = 2 * p + 1, NT = 8 * p + 8, NTA = 8 * p + 4;
    const unsigned lds0 = (unsigned)(uintptr_t)lds;
#define MD_DMA(t) do { int l_ = lane; asm volatile("" : "+v"(l_)); \
        glds16(Ks + (size_t)l_ * 64 + wid * 8 + (size_t)(t) * 4096, (unsigned)__builtin_amdgcn_readfirstlane((int)(lds0 + D_KB + ((t) & 3) * 8192 + wid * 1024))); \
        glds16(Vs + (size_t)(16 * (wid & 3) + (l_ >> 2)) * 64 + (wid >> 2) * 32 + (l_ & 3) * 8 + (size_t)(t) * 4096, (unsigned)__builtin_amdgcn_readfirstlane((int)(lds0 + D_VB + ((t) & 3) * 8192 + wid * 1024))); } while (0)
    for (int i = tid; i < TBLB_N / 4; i += 512) ((LAS f32x4*)tbl)[i] = ((const f32x4*)tblg)[i];
    {   LAS bf16_t* kmh = (LAS bf16_t*)(lds + D_KM); LAS bf16_t* kml = kmh + 32 * 64;
        for (int i = tid; i < 32 * 64; i += 512) { const int j = i >> 6, d = i & 63; float x = 0.f;
            if (j < qbB) x = (kmp0[(size_t)j * 1024 + d] + kmp1[(size_t)j * 1024 + d]) * (1.f / 256.f);
            const unsigned hb = cvtpk(x, 0.f) & 0xffffu; const float xl = x - bf2f((unsigned short)hb);
            kmh[i] = (bf16_t)hb; kml[i] = (bf16_t)(cvtpk(xl, 0.f) & 0xffffu); } }
    const int qt = (wid < 4) ? wid : 11 - wid;
    const int qrowA = qbA * 256 + qt * 32 + r32, qrowB = qrowA + 256;
    bf16x8 qrA[4], qrB[4];
#pragma unroll
    for (int d0 = 0; d0 < 4; ++d0) { qrA[d0] = *(const bf16x8*)(Qs + (size_t)qrowA * 64 + d0 * 16 + hi * 8); qrB[d0] = *(const bf16x8*)(Qs + (size_t)qrowB * 64 + d0 * 16 + hi * 8); }
    MD_DMA(0); MD_DMA(1);
    ATT_WAIT_BAR();
    MD_DMA(2);
    unsigned selA = 0u, selB = 0u;
#define MD_GATE(SEL, QR, QB) do { f32x16 g0 = {0.f, 0.f, 0.f, 0.f, 0.f, 0.f, 0.f, 0.f, 0.f, 0.f, 0.f, 0.f, 0.f, 0.f, 0.f, 0.f}; \
        const LAS unsigned char* kb_ = lds + D_KM + r32 * 128 + hi * 16; \
        _Pragma("unroll") for (int d0 = 0; d0 < 4; ++d0) { const bf16x8 ah = *(const LAS bf16x8*)(kb_ + d0 * 32), al = *(const LAS bf16x8*)(kb_ + 4096 + d0 * 32); \
            g0 = __builtin_amdgcn_mfma_f32_32x32x16_bf16(ah, QR[d0], g0, 0, 0, 0); g0 = __builtin_amdgcn_mfma_f32_32x32x16_bf16(al, QR[d0], g0, 0, 0, 0); } \
        float gt[16]; \
        _Pragma("unroll") for (int r = 0; r < 8; ++r) { const float mine = g0[r], oth = __shfl_xor(mine, 32); const int jm = (r & 3) + 8 * (r >> 2); gt[jm] = hi ? oth : mine; gt[jm + 4] = hi ? mine : oth; } \
        _Pragma("unroll") for (int rep = 0; rep < 3; ++rep) { float best = -__builtin_inff(); int bi = -1; \
            _Pragma("unroll") for (int j = 0; j < 16; ++j) { const bool ok = (j < (QB)) && !((SEL >> j) & 1u) && (gt[j] > best); if (ok) { best = gt[j]; bi = j; } } \
            if (bi >= 0) SEL |= 1u << bi; } \
        SEL |= 1u << (QB); } while (0)
    MD_GATE(selA, qrA, qbA);
    MD_GATE(selB, qrB, qbB);
    LAS unsigned char* qal = lds + D_OST + wid * 4096 + lane * 16;
#pragma unroll
    for (int d0 = 0; d0 < 4; ++d0) *(LAS bf16x8*)(qal + d0 * 1024) = qrA[d0];
#define QA(d0) (*(const LAS bf16x8*)(qal + (d0) * 1024))
#define QB_(d0) qrB[d0]
    const int vb0 = (int)(unsigned)(uintptr_t)(lds + D_VB) + ((lane >> 4) & 1) * 32 + (lane & 3) * 8 + (4 * hi + ((lane & 15) >> 2)) * 64;
    f32x16 oA[2], oB[2]; float olA = 0.f, olB = 0.f; oA[0] = (f32x16){0.f, 0.f, 0.f, 0.f, 0.f, 0.f, 0.f, 0.f, 0.f, 0.f, 0.f, 0.f, 0.f, 0.f, 0.f, 0.f}; oA[1] = oA[0]; oB[0] = oA[0]; oB[1] = oA[0];
#define MD_QK(P0, P1, SEL, QROW, QR, t) do { const int kb_ = 64 * (t); const bool sel_ = (SEL >> ((t) >> 2)) & 1u; \
        const int base_ = sel_ ? (4095 - (QROW - kb_) + 4 * hi) : (4096 + 4 * hi); const LAS float* tp_ = tbl + base_; \
        _Pragma("unroll") for (int r = 0; r < 16; ++r) { const int cc = (r & 3) + 8 * (r >> 2); P0[r] = tp_[cc]; P1[r] = tp_[cc + 32]; } \
        const LAS unsigned char* kq_ = lds + D_KB + ((t) & 3) * 8192 + hi * 1024 + r32 * 16; \
        _Pragma("unroll") for (int d0 = 0; d0 < 4; ++d0) { const bf16x8 kf0_ = *(const LAS bf16x8*)(kq_ + d0 * 2048), kf1_ = *(const LAS bf16x8*)(kq_ + d0 * 2048 + 512); \
            const bf16x8 qf_ = QR(d0); P0 = __builtin_amdgcn_mfma_f32_32x32x16_bf16(kf0_, qf_, P0, 0, 0, 0); P1 = __builtin_amdgcn_mfma_f32_32x32x16_bf16(kf1_, qf_, P1, 0, 0, 0); } } while (0)
#define MD_EXP(PW, P0, P1, OL) do { float s_ = 0.f; \
        _Pragma("unroll") for (int r = 0; r < 16; ++r) { P0[r] = __builtin_amdgcn_exp2f(P0[r]); P1[r] = __builtin_amdgcn_exp2f(P1[r]); s_ += P0[r] + P1[r]; } OL += s_; \
        _Pragma("unroll") for (int k = 0; k < 2; ++k) { PW[k] = (u32x4){cvtpk(P0[8 * k], P0[8 * k + 1]), cvtpk(P0[8 * k + 2], P0[8 * k + 3]), cvtpk(P0[8 * k + 4], P0[8 * k + 5]), cvtpk(P0[8 * k + 6], P0[8 * k + 7])}; \
            PW[2 + k] = (u32x4){cvtpk(P1[8 * k], P1[8 * k + 1]), cvtpk(P1[8 * k + 2], P1[8 * k + 3]), cvtpk(P1[8 * k + 4], P1[8 * k + 5]), cvtpk(P1[8 * k + 6], P1[8 * k + 7])}; } } while (0)
#define MD_PV(OO, PW, t) do { const int vb_ = vb0 + ((t) & 3) * 8192; \
        _Pragma("unroll") for (int d0 = 0; d0 < 2; ++d0) { s16x4 vlo[4], vhi[4]; \
            _Pragma("unroll") for (int ks = 0; ks < 4; ++ks) { vlo[ks] = __builtin_bit_cast(s16x4, __builtin_amdgcn_ds_read_tr16_b64_v4i16((LAS s16x4*)(uintptr_t)(unsigned)(vb_ + d0 * 4096 + ks * 1024))); \
                                                             vhi[ks] = __builtin_bit_cast(s16x4, __builtin_amdgcn_ds_read_tr16_b64_v4i16((LAS s16x4*)(uintptr_t)(unsigned)(vb_ + d0 * 4096 + ks * 1024 + 512))); } \
            _Pragma("unroll") for (int ks = 0; ks < 4; ++ks) { const bf16x8 vf = (bf16x8){vlo[ks][0], vlo[ks][1], vlo[ks][2], vlo[ks][3], vhi[ks][0], vhi[ks][1], vhi[ks][2], vhi[ks][3]}; \
                OO[d0] = __builtin_amdgcn_mfma_f32_32x32x16_bf16(__builtin_bit_cast(bf16x8, PW[ks]), vf, OO[d0], 0, 0, 0); } } } while (0)
#define MD_SB() __builtin_amdgcn_sched_barrier(0)
    for (int t = 0; t < NT; ++t) {
        const bool dma = (t + 3 < NT);
        if (dma) MD_DMA(t + 3);
        const bool needA = (t < NTA) && (t - 8 * p <= (qt >> 1)), needB = (t < NTA) || (t - NTA <= (qt >> 1));
        if (needA) {
            f32x16 a0, a1, b0, b1; u32x4 pwa[4], pwb[4];
            { const int kb_ = 64 * t; const bool sa_ = (selA >> (t >> 2)) & 1u, sb_ = (selB >> (t >> 2)) & 1u;
              const LAS float* ta_ = tbl + (sa_ ? (4095 - (qrowA - kb_) + 4 * hi) : (4096 + 4 * hi)); const LAS float* tb_ = tbl + (sb_ ? (4095 - (qrowB - kb_) + 4 * hi) : (4096 + 4 * hi));
#pragma unroll
              for (int r = 0; r < 16; ++r) { const int cc = (r & 3) + 8 * (r >> 2); a0[r] = ta_[cc]; a1[r] = ta_[cc + 32]; b0[r] = tb_[cc]; b1[r] = tb_[cc + 32]; }
              const LAS unsigned char* kq_ = lds + D_KB + (t & 3) * 8192 + hi * 1024 + r32 * 16;
#pragma unroll
              for (int d0 = 0; d0 < 4; ++d0) { const bf16x8 kf0_ = *(const LAS bf16x8*)(kq_ + d0 * 2048), kf1_ = *(const LAS bf16x8*)(kq_ + d0 * 2048 + 512); const bf16x8 qa_ = QA(d0), qb_ = qrB[d0];
                  a0 = __builtin_amdgcn_mfma_f32_32x32x16_bf16(kf0_, qa_, a0, 0, 0, 0); a1 = __builtin_amdgcn_mfma_f32_32x32x16_bf16(kf1_, qa_, a1, 0, 0, 0);
                  b0 = __builtin_amdgcn_mfma_f32_32x32x16_bf16(kf0_, qb_, b0, 0, 0, 0); b1 = __builtin_amdgcn_mfma_f32_32x32x16_bf16(kf1_, qb_, b1, 0, 0, 0); } }
            MD_EXP(pwa, a0, a1, olA); MD_EXP(pwb, b0, b1, olB);
            { const int vb_ = vb0 + (t & 3) * 8192;
#pragma unroll
              for (int d0 = 0; d0 < 2; ++d0) { s16x4 vlo[4], vhi[4];
#pragma unroll
                  for (int ks = 0; ks < 4; ++ks) { vlo[ks] = __builtin_bit_cast(s16x4, __builtin_amdgcn_ds_read_tr16_b64_v4i16((LAS s16x4*)(uintptr_t)(unsigned)(vb_ + d0 * 4096 + ks * 1024)));
                                                   vhi[ks] = __builtin_bit_cast(s16x4, __builtin_amdgcn_ds_read_tr16_b64_v4i16((LAS s16x4*)(uintptr_t)(unsigned)(vb_ + d0 * 4096 + ks * 1024 + 512))); }
#pragma unroll
                  for (int ks = 0; ks < 4; ++ks) { const bf16x8 vf = (bf16x8){vlo[ks][0], vlo[ks][1], vlo[ks][2], vlo[ks][3], vhi[ks][0], vhi[ks][1], vhi[ks][2], vhi[ks][3]};
                      oA[d0] = __builtin_amdgcn_mfma_f32_32x32x16_bf16(__builtin_bit_cast(bf16x8, pwa[ks]), vf, oA[d0], 0, 0, 0);
                      oB[d0] = __builtin_amdgcn_mfma_f32_32x32x16_bf16(__builtin_bit_cast(bf16x8, pwb[ks]), vf, oB[d0], 0, 0, 0); } } }
        } else if (needB) {
            f32x16 b0, b1; u32x4 pwb[4];
            MD_QK(b0, b1, selB, qrowB, QB_, t); MD_EXP(pwb, b0, b1, olB); MD_PV(oB, pwb, t);
        }
        if (t + 3 < NT) asm volatile("s_waitcnt vmcnt(4) lgkmcnt(0)\n\ts_barrier" ::: "memory");
        else if (t + 2 < NT) asm volatile("s_waitcnt vmcnt(2) lgkmcnt(0)\n\ts_barrier" ::: "memory");
        else ATT_WAIT_BAR();
    }
    LAS bf16_t* stg = (LAS bf16_t*)(lds + D_OST) + wid * 2048;
    LAS float* wsf = (LAS float*)(lds + D_KM) + wid * 64;
#define MD_OUT(OO, OL, QB) do { { float l_ = OL + __shfl_xor(OL, 32); if (hi == 0) wsf[r32] = __builtin_amdgcn_rcpf(l_); } asm volatile("s_waitcnt lgkmcnt(0)" ::: "memory"); \
        _Pragma("unroll") for (int r = 0; r < 16; ++r) { const int orow = crow(r, hi); const float sc = wsf[orow]; \
            _Pragma("unroll") for (int d0 = 0; d0 < 2; ++d0) stg[orow * 64 + d0 * 32 + r32] = (bf16_t)(cvtpk(OO[d0][r] * sc, 0.f) & 0xffffu); } \
        asm volatile("s_waitcnt lgkmcnt(0)" ::: "memory"); \
        _Pragma("unroll") for (int i = 0; i < 4; ++i) { const int row = i * 8 + (lane >> 3), ch = lane & 7; const u32x4 v = *(const LAS u32x4*)(stg + row * 64 + ch * 8); \
            *(u32x4*)(O + (size_t)((QB) * 256 + qt * 32 + row) * 1024 + ch * 8) = v; } \
        asm volatile("s_waitcnt lgkmcnt(0)" ::: "memory"); } while (0)
    MD_OUT(oA, olA, qbA);
    MD_OUT(oB, olB, qbB);
    ATT_WAIT_BAR();
#undef MD_DMA
#undef MD_GATE
#undef MD_QK
#undef MD_EXP
#undef MD_PV
#undef MD_SB
#undef QA
#undef QB_
#undef MD_OUT
}
}

constexpr int NWAVES = 8;
#ifndef MK_N_LAUNCHES
#define MK_N_LAUNCHES 1
#endif
constexpr int N_LAUNCHES = MK_N_LAUNCHES, PER_PHASE = 12;
constexpr size_t MiB = 1u << 20;
constexpr size_t WS_CTL = 0, CTL_ZERO_BYTES = 32 * 1024;
constexpr size_t WS_SS = 1 * MiB;
constexpr size_t WS_KM = WS_SS + 512 * 1024;
constexpr size_t WS_TBLB = 2 * MiB;
constexpr size_t WS_TBLA = WS_TBLB + 512 * 1024;
constexpr size_t WS_LA = 3 * MiB;
constexpr size_t WS_W = 6 * MiB;
constexpr size_t W_QKV0 = WS_W, W_O0 = W_QKV0 + 9 * MiB, W_QKV1 = W_O0 + 1 * MiB, W_O1 = W_QKV1 + 6 * MiB, W_UP0 = W_O1 + 2 * MiB, W_UP1 = W_UP0 + 8 * MiB, W_DN0 = W_UP1 + 8 * MiB, W_DN1 = W_DN0 + 8 * MiB;
constexpr size_t WS_HB = 56 * MiB;
constexpr size_t WS_OG = 56 * MiB;
constexpr size_t WS_QKV = 104 * MiB;
constexpr size_t WS_O0 = 104 * MiB;
constexpr size_t WS_O1 = 200 * MiB;
constexpr size_t WS_H = 104 * MiB;
constexpr size_t WS_END = 256 * MiB;
static_assert(W_DN1 + 8 * MiB == WS_HB && WS_H + 128 * MiB <= WS_END && WS_QKV + 144 * MiB <= WS_END, "d_ws map");
constexpr int CW_BAR = 4096;
constexpr int RING_BYTES = 131072, LDS_BYTES = 163840, LDSCTL_OFF = LDS_BYTES - 512, MISC_OFF = LDSCTL_OFF + 320;
static_assert(att::S_END <= LDSCTL_OFF && att::D_END <= RING_BYTES, "attention LDS");

typedef GAS unsigned gu32;
#define RLX_AGENT __ATOMIC_RELAXED, __HIP_MEMORY_SCOPE_AGENT
#define XB_TMO      128
#define XB_XCNT(j)  (256  + 64 * (j))
#define XB_XSUB(j)  (1280 + 64 * (j))
#define XB_XGEN(j)  (2304 + 64 * (j))
#define XB_TOP      3328
#define XB_TOPGEN   3392
#define XCD_BAR_WORDS 3456
#define XB_SPIN_CAP (1u << 18)
__device__ __forceinline__ unsigned xb_ld(unsigned* p)              { return __hip_atomic_load(p, __ATOMIC_RELAXED, __HIP_MEMORY_SCOPE_AGENT); }
__device__ __forceinline__ unsigned xb_add(unsigned* p, unsigned v) { return __hip_atomic_fetch_add(p, v, __ATOMIC_RELAXED, __HIP_MEMORY_SCOPE_AGENT); }
__device__ __forceinline__ unsigned xb_xcc_id() { return (unsigned)__builtin_amdgcn_s_getreg((3 << 11) | 20) & 0xFu; }
#define XB_SPIN(cond, bar) do { unsigned _sp = 0; while (cond) { __builtin_amdgcn_s_sleep(1); \
    if ((++_sp & 255u) == 0u) { if (xb_ld(&(bar)[XB_TMO])) break; if (_sp > XB_SPIN_CAP) { atomicAdd(&(bar)[XB_TMO], 1u); break; } } } } while (0)
struct XcdBarrier { unsigned* bar; unsigned x; volatile LAS unsigned* st; };
__device__ __forceinline__ XcdBarrier xcd_barrier_post(unsigned* bar, volatile LAS unsigned* st) {
    XcdBarrier b; b.bar = bar; b.x = xb_xcc_id(); b.st = st;
    if (threadIdx.x == 0) (void)xb_add(&bar[XB_XCNT(b.x)], 1u);
    return b;
}
__device__ __forceinline__ void xcd_barrier_complete(unsigned* bar, unsigned x, unsigned& nloc, unsigned& nx) {
    const unsigned G = gridDim.x * gridDim.y * gridDim.z;
    unsigned sum, cnt, mine, sp = 0u;
    for (;;) {
        sum = 0u; cnt = 0u; mine = 0u;
#pragma unroll
        for (unsigned j = 0; j < 16; ++j) { const unsigned c = xb_ld(&bar[XB_XCNT(j)]); sum += c; cnt += (c > 0u) ? 1u : 0u; mine = (j == x) ? c : mine; }
        if (sum == G) break;
        __builtin_amdgcn_s_sleep(1);
        if ((++sp & 255u) == 0u) { if (xb_ld(&bar[XB_TMO])) break; if (sp > XB_SPIN_CAP) { atomicAdd(&bar[XB_TMO], 1u); break; } }
    }
    nloc = mine > 0u ? mine : 1u; nx = cnt > 0u ? cnt : 1u;
}
__device__ __forceinline__ void xcd_barrier(const XcdBarrier& b) {
    asm volatile("s_waitcnt vmcnt(0)" ::: "memory");
    __syncthreads();
    if (threadIdx.x == 0) {
        unsigned* bar = b.bar;
        __builtin_amdgcn_s_waitcnt(0);
        unsigned nloc = b.st[0], nx = b.st[1];
        if (nloc == 0u) { xcd_barrier_complete(bar, b.x, nloc, nx); b.st[0] = nloc; b.st[1] = nx; }
        const unsigned old = xb_add(&bar[XB_XSUB(b.x)], 1u);
        const unsigned gen = old / nloc;
        if (old + 1u == (gen + 1u) * nloc) {
            __builtin_amdgcn_fence(__ATOMIC_RELEASE, "agent");
            asm volatile("s_waitcnt vmcnt(0)" ::: "memory");
            const unsigned og = xb_add(&bar[XB_TOP], 1u);
            const unsigned tg = og / nx;
            if (og + 1u == (tg + 1u) * nx) xb_add(&bar[XB_TOPGEN], 1u);
            else XB_SPIN(xb_ld(&bar[XB_TOPGEN]) == tg, bar);
            __builtin_amdgcn_fence(__ATOMIC_ACQUIRE, "agent");
            xb_add(&bar[XB_XGEN(b.x)], 1u);
            asm volatile("s_waitcnt vmcnt(0)" ::: "memory");
        } else {
            XB_SPIN(xb_ld(&bar[XB_XGEN(b.x)]) == gen, bar);
            __builtin_amdgcn_fence(__ATOMIC_ACQUIRE, "agent");
            asm volatile("s_waitcnt vmcnt(0)" ::: "memory");
        }
    }
    __syncthreads();
}

__device__ __forceinline__ float wave_sum(float v) {
#pragma unroll
    for (int o = 1; o < 64; o <<= 1) v += __shfl_xor(v, o);
    return v;
}
__device__ __forceinline__ float wave_max(float v) {
#pragma unroll
    for (int o = 1; o < 64; o <<= 1) v = fmaxf(v, __shfl_xor(v, o));
    return v;
}
__device__ __forceinline__ void p0_transpose_item(const float* W, int K, int N, bf16_t* WT, const float* gain, bool perm, LAS float* scr, int item, int lane) {
    const int nblk = N / 32, kb = item / nblk, nb = item % nblk, k0 = 64 * kb, n0 = 32 * nb;
    const int kr = lane >> 3, c4 = (lane & 7) * 4;
    f32x4 v[8]; float gs[8];
#pragma unroll
    for (int i = 0; i < 8; ++i) { v[i] = *(const f32x4*)(W + (size_t)(k0 + 8 * i + kr) * N + n0 + c4); gs[i] = gain ? gain[k0 + 8 * i + kr] : 1.f; }
#pragma unroll
    for (int i = 0; i < 8; ++i) { LAS float* s = scr + (8 * i + kr) * 33 + c4; s[0] = v[i][0] * gs[i]; s[1] = v[i][1] * gs[i]; s[2] = v[i][2] * gs[i]; s[3] = v[i][3] * gs[i]; }
    asm volatile("s_waitcnt lgkmcnt(0)" ::: "memory");
    const int c = lane & 7;
    const int orow0 = perm ? ((n0 & ~255) + ((n0 >> 5) & 1) * 128 + ((n0 >> 6) & 3) * 32) : n0;
#pragma unroll
    for (int j = 0; j < 4; ++j) { const int n = (lane >> 3) + 8 * j; const LAS float* s = scr + (8 * c) * 33 + n;
        u32x4 o; o.x = cvtpk(s[0 * 33], s[1 * 33]); o.y = cvtpk(s[2 * 33], s[3 * 33]); o.z = cvtpk(s[4 * 33], s[5 * 33]); o.w = cvtpk(s[6 * 33], s[7 * 33]);
        *(u32x4*)(WT + (size_t)(orow0 + n) * K + k0 + 8 * c) = o; }
    asm volatile("s_waitcnt lgkmcnt(0)" ::: "memory");
}
__device__ __forceinline__ int t5_bucket(int n) {
    if (n < 16) return n;
    const int thr[15] = {22, 30, 40, 54, 73, 99, 134, 182, 246, 332, 450, 609, 825, 1117, 1513};
    int b = 16;
#pragma unroll
    for (int k = 0; k < 15; ++k) b += (n >= thr[k]) ? 1 : 0;
    return b;
}

struct Args { const float* in[14]; float* out; unsigned char* ws; int ph_lo, ph_hi, li, pad; };

__global__ void __launch_bounds__(NWAVES * 64, 2) hybrid_fwd(Args args) {
    extern __shared__ __attribute__((aligned(16))) unsigned char lds_raw[];
    LAS unsigned char* lds = (LAS unsigned char*)lds_raw;
    volatile LAS unsigned* MISC = (volatile LAS unsigned*)(lds + MISC_OFF);
    const int tid = threadIdx.x, lane = tid & 63, wave = __builtin_amdgcn_readfirstlane(tid >> 6);
    const int G = gridDim.x, bx = blockIdx.x, vcu = (G % 8 == 0) ? (bx % 8) * (G / 8) + bx / 8 : bx;
    unsigned char* ws = args.ws;
    unsigned* ctl = (unsigned*)(ws + WS_CTL);
    const float* x = args.in[0]; const float* rel_bias = args.in[1]; const float* norm_mix = args.in[2]; const float* norm_ffn = args.in[3];
    const float* a_w_qkv = args.in[4]; const float* a_q_gain = args.in[5]; const float* a_k_gain = args.in[6]; const float* a_w_o = args.in[7];
    const float* b_w_qkv = args.in[8]; const float* b_q_gain = args.in[9]; const float* b_k_gain = args.in[10]; const float* b_w_o = args.in[11];
    const float* ffn_w1 = args.in[12]; const float* ffn_w2 = args.in[13];
    float* out = args.out;
    float* ssp = (float*)(ws + WS_SS); float* kmp = (float*)(ws + WS_KM); float* tblB = (float*)(ws + WS_TBLB); float* tblA = (float*)(ws + WS_TBLA); float* la = (float*)(ws + WS_LA);
    bf16_t* HB = (bf16_t*)(ws + WS_HB); bf16_t* OG = (bf16_t*)(ws + WS_OG); bf16_t* QKV = (bf16_t*)(ws + WS_QKV); bf16_t* O0 = (bf16_t*)(ws + WS_O0); bf16_t* O1 = (bf16_t*)(ws + WS_O1); bf16_t* HH = (bf16_t*)(ws + WS_H);

    for (int u = tid; u < (LDS_BYTES - LDSCTL_OFF) / 4; u += NWAVES * 64) ((LAS unsigned*)(lds + LDSCTL_OFF))[u] = 0u;
    __syncthreads();
    XcdBarrier bar; bar.bar = ctl + CW_BAR; bar.x = 0; bar.st = nullptr;
    if (N_LAUNCHES != PER_PHASE) bar = xcd_barrier_post(ctl + CW_BAR, MISC + 8);
#define GRID_BAR() do { if (N_LAUNCHES != PER_PHASE) xcd_barrier(bar); } while (0)
    const int lo = args.ph_lo, hi = args.ph_hi;
#define IN(k) (lo <= (k) && (k) < hi)
#define BOTH(k) (IN(k) && IN((k) + 1))

    constexpr int I0 = (DM / 64) * (NQKV0 / 32), I1 = (NO0 / 64) * (DM / 32), I2 = (DM / 64) * (NQKV1 / 32), I3 = (NO1 / 64) * (DM / 32), I4 = (DM / 64) * (FF / 32), I5 = (FF / 64) * (DM / 32);
    constexpr int NITEMS_A = I0 + I1, NITEMS = NITEMS_A + I4 + I5 + I2 + I3 + I4 + I5;
#define P0_ITEM(it_) do { int r = (it_); LAS float* scr_ = (LAS float*)(lds + wave * 16384); \
        if (r < I0) { p0_transpose_item(a_w_qkv, DM, NQKV0, (bf16_t*)(ws + W_QKV0), norm_mix, true, scr_, r, lane); break; } r -= I0; \
        if (r < I1) { p0_transpose_item(a_w_o, NO0, DM, (bf16_t*)(ws + W_O0), nullptr, false, scr_, r, lane); break; } r -= I1; \
        if (r < I4) { p0_transpose_item(ffn_w1, DM, FF, (bf16_t*)(ws + W_UP0), norm_ffn, false, scr_, r, lane); break; } r -= I4; \
        if (r < I5) { p0_transpose_item(ffn_w2, FF, DM, (bf16_t*)(ws + W_DN0), nullptr, false, scr_, r, lane); break; } r -= I5; \
        if (r < I2) { p0_transpose_item(b_w_qkv, DM, NQKV1, (bf16_t*)(ws + W_QKV1), norm_mix + DM, true, scr_, r, lane); break; } r -= I2; \
        if (r < I3) { p0_transpose_item(b_w_o, NO1, DM, (bf16_t*)(ws + W_O1), nullptr, false, scr_, r, lane); break; } r -= I3; \
        if (r < I4) { p0_transpose_item(ffn_w1 + (size_t)DM * FF, DM, FF, (bf16_t*)(ws + W_UP1), norm_ffn + DM, false, scr_, r, lane); break; } r -= I4; \
        p0_transpose_item(ffn_w2 + (size_t)FF * DM, FF, DM, (bf16_t*)(ws + W_DN1), nullptr, false, scr_, r, lane); } while (0)
    if (IN(0)) {
        const int gw = vcu * NWAVES + wave, NGW = G * NWAVES;
        for (int it = gw; it < NITEMS_A; it += NGW) P0_ITEM(it);
        for (int m = 2 * gw; m < MTOK; m += 2 * NGW) {
            f32x4 v[2][4]; float s[2] = {0.f, 0.f};
#pragma unroll
            for (int q = 0; q < 2; ++q)
#pragma unroll
                for (int j = 0; j < 2; ++j) { const f32x4* xp = (const f32x4*)(x + (size_t)(m + q) * DM + 512 * j + 8 * lane); v[q][2 * j] = xp[0]; v[q][2 * j + 1] = xp[1]; }
#pragma unroll
            for (int q = 0; q < 2; ++q) {
#pragma unroll
                for (int j = 0; j < 4; ++j) s[q] += (v[q][j][0] * v[q][j][0] + v[q][j][1] * v[q][j][1]) + (v[q][j][2] * v[q][j][2] + v[q][j][3] * v[q][j][3]);
                s[q] = wave_sum(s[q]);
#pragma unroll
                for (int j = 0; j < 2; ++j) { u32x4 w; w.x = cvtpk(v[q][2 * j][0], v[q][2 * j][1]); w.y = cvtpk(v[q][2 * j][2], v[q][2 * j][3]); w.z = cvtpk(v[q][2 * j + 1][0], v[q][2 * j + 1][1]); w.w = cvtpk(v[q][2 * j + 1][2], v[q][2 * j + 1][3]);
                    *(u32x4*)(HB + (size_t)(m + q) * DM + 512 * j + 8 * lane) = w; }
                if (lane == 0) *(f32x4*)(ssp + (size_t)(m + q) * 4) = (f32x4){s[q], 0.f, 0.f, 0.f};
            }
        }
        {
            float mb = 0.f;
            for (int i = lane; i < 32 * 24; i += 64) mb = fmaxf(mb, rel_bias[i]);
            mb = wave_max(mb);
            const float refA = (8.f * wave_max(fabsf(a_q_gain[lane])) * wave_max(fabsf(a_k_gain[lane])) + mb) * LOG2E;
            const float refB = (8.f * wave_max(fabsf(b_q_gain[lane])) * wave_max(fabsf(b_k_gain[lane])) + mb) * LOG2E;
            const int gt = vcu * 512 + tid, NGT = G * 512;
            for (int e = gt; e < 16 * TBLB_N; e += NGT) { const int h = e / TBLB_N, idx = e % TBLB_N, dist = 4095 - idx;
                tblB[e] = (dist < 0) ? NEGV : rel_bias[t5_bucket(dist) * 24 + h] * LOG2E - refB; }
            for (int e = gt; e < 24 * TBLA_N; e += NGT) { const int col = e / TBLA_N, idx = e % TBLA_N, dist = 383 - idx, g = col >> 3;
                tblA[e] = (dist < 0 || dist > 128) ? NEGV : rel_bias[t5_bucket(dist << (2 * g)) * 24 + col] * LOG2E - refA; }
        }
        if (BOTH(0)) GRID_BAR();
    }
    if (IN(1)) {
        pg8::Gemm g{HB, (const bf16_t*)(ws + W_QKV0), MTOK, NQKV0, DM}; pg8::StaticOrder S; S.init(MTOK, NQKV0, G, bx);
        pg8::EpiQKV E{0, ssp, a_q_gain, a_k_gain, QKV, nullptr};
        pg8::gemm_phase<pg8::EpiQKV, pg8::StaticOrder, true, true>(lds, g, S, E);
        {
            const int nun = (MTOK / 256) * (NQKV0 / 256), full = nun % G, nidle = full ? G - full : G;
            if (bx >= full || full == 0) { const int iw = ((full ? bx - full : bx) * NWAVES + wave), NIW = nidle * NWAVES;
                for (int it = NITEMS_A + iw; it < NITEMS; it += NIW) P0_ITEM(it); }
        }
        if (BOTH(1)) GRID_BAR();
    }
    if (IN(2)) {
        const int nit = 768, perw = (nit + G - 1) / G;
        for (int k = 0; k < 3; ++k) {
            int item;
            if (G == 256) item = (k == 0) ? vcu : 256 + 2 * vcu + (k - 1);
            else { item = vcu * perw + k; if (k >= perw || item >= nit) break; }
            int g, sq, i0, R;
            if (item < 128) { g = 0; sq = item >> 2; i0 = (item & 3) * 32; R = 4; }
            else if (item < 256) { g = 1; sq = item - 128; i0 = 0; R = 4; }
            else { g = 2; sq = item - 256; i0 = 0; R = 1; }
            const int sh = 2 * g, dil = 1 << sh, Lg = SEQ >> sh, hh = sq & 7, vb = sq >> 3, b = vb >> sh, c = vb & (dil - 1);
            att::StreamDesc U;
            const size_t seqoff = (size_t)sq * Lg * 64;
            U.Q = QKV + (size_t)(0 * 3 + g) * ((size_t)MTOK * 512) + seqoff; U.K = QKV + (size_t)(1 * 3 + g) * ((size_t)MTOK * 512) + seqoff; U.V = QKV + (size_t)(2 * 3 + g) * ((size_t)MTOK * 512) + seqoff;
            U.i0 = i0; U.R = R; U.tblg = tblA + (size_t)(g * 8 + hh) * TBLA_N;
            U.O = OG + (size_t)g * ((size_t)MTOK * 512) + hh * 64; U.o_row0 = b * SEQ + c; U.o_rstride = dil;
            U.L = la + (size_t)g * ((size_t)MTOK * 8) + hh;
            att::stream(lds, U);
        }
        if (BOTH(2)) GRID_BAR();
    }
    if (IN(3)) {
        const int gt = vcu * 512 + tid, NGT = G * 512;
        for (int e = gt; e < MTOK * 64; e += NGT) {
            const int row = e >> 6, c8 = e & 63, hh = c8 >> 3;
            float acc8[8] = {0.f, 0.f, 0.f, 0.f, 0.f, 0.f, 0.f, 0.f}; float l = 0.f;
#pragma unroll
            for (int g = 0; g < 3; ++g) { const u32x4 w = *(const u32x4*)(OG + (size_t)g * ((size_t)MTOK * 512) + (size_t)row * 512 + c8 * 8);
                l += la[(size_t)g * ((size_t)MTOK * 8) + (size_t)row * 8 + hh];
#pragma unroll
                for (int k = 0; k < 4; ++k) { acc8[2 * k] += __builtin_bit_cast(float, w[k] << 16); acc8[2 * k + 1] += __builtin_bit_cast(float, w[k] & 0xffff0000u); } }
            const float rl = 1.f / l; u32x4 o;
            o.x = cvtpk(acc8[0] * rl, acc8[1] * rl); o.y = cvtpk(acc8[2] * rl, acc8[3] * rl); o.z = cvtpk(acc8[4] * rl, acc8[5] * rl); o.w = cvtpk(acc8[6] * rl, acc8[7] * rl);
            *(u32x4*)(O0 + (size_t)row * 512 + c8 * 8) = o;
        }
        if (BOTH(3)) GRID_BAR();
    }
    if (IN(4)) {
        pg8::Gemm g{O0, (const bf16_t*)(ws + W_O0), MTOK, DM, NO0}; pg8::StaticOrder S; S.init(MTOK, DM, G, bx);
        pg8::EpiRes<0> E{x, out, HB, ssp};
        pg8::gemm_phase<pg8::EpiRes<0>, pg8::StaticOrder, false, true>(lds, g, S, E);
        if (BOTH(4)) GRID_BAR();
    }
#define UP_PHASE(PU, WUP) \
    if (IN(PU)) { pg8::Gemm g{HB, (const bf16_t*)(ws + (WUP)), MTOK, FF, DM}; pg8::StaticOrder S; S.init(MTOK, FF, G, bx); pg8::EpiUp E{ssp, HH}; \
        pg8::gemm_phase<pg8::EpiUp, pg8::StaticOrder, true, true>(lds, g, S, E); if (BOTH(PU)) GRID_BAR(); }
#define DN_PHASE(PD, WDN, MODE) \
    if (IN(PD)) { pg8::Gemm g{HH, (const bf16_t*)(ws + (WDN)), MTOK, DM, FF}; pg8::StaticOrder S; S.init(MTOK, DM, G, bx); pg8::EpiRes<MODE> E{nullptr, out, HB, ssp}; \
        pg8::gemm_phase<pg8::EpiRes<MODE>, pg8::StaticOrder, false, true>(lds, g, S, E); if (BOTH(PD)) GRID_BAR(); }
    UP_PHASE(5, W_UP0)
    DN_PHASE(6, W_DN0, 1)
    if (IN(7)) {
        pg8::Gemm g{HB, (const bf16_t*)(ws + W_QKV1), MTOK, NQKV1, DM}; pg8::StaticOrder S; S.init(MTOK, NQKV1, G, bx);
        pg8::EpiQKV E{1, ssp, b_q_gain, b_k_gain, QKV, kmp};
        pg8::gemm_phase<pg8::EpiQKV, pg8::StaticOrder, true, true>(lds, g, S, E);
        if (BOTH(7)) GRID_BAR();
    }
    if (IN(8)) {
        const int per = (512 + G - 1) / G;
        for (int i = 0; i < per; ++i) {
            int bh, p;
            if (per == 2) { const int s = vcu & 3; bh = vcu >> 2; p = (i == 0) ? s : 7 - s; }
            else { const int uid = vcu * per + i; if (uid >= 512) break; bh = uid >> 3; p = uid & 7; }
            const int b = bh >> 4, h = bh & 15;
            const size_t seqoff = (size_t)bh * SEQ * 64;
            att::moba_pair(lds, p, QKV + seqoff, QKV + (size_t)MTOK * 1024 + seqoff, QKV + (size_t)2 * MTOK * 1024 + seqoff, tblB + (size_t)h * TBLB_N,
                           kmp + (((size_t)0 * BATCH + b) * 16 * 16 + h) * 64, kmp + (((size_t)1 * BATCH + b) * 16 * 16 + h) * 64, O1 + (size_t)(b * SEQ) * 1024 + h * 64);
        }
        if (BOTH(8)) GRID_BAR();
    }
    if (IN(9)) {
        pg8::Gemm g{O1, (const bf16_t*)(ws + W_O1), MTOK, DM, NO1}; pg8::StaticOrder S; S.init(MTOK, DM, G, bx);
        pg8::EpiRes<1> E{nullptr, out, HB, ssp};
        pg8::gemm_phase<pg8::EpiRes<1>, pg8::StaticOrder, false, true>(lds, g, S, E);
        if (BOTH(9)) GRID_BAR();
    }
    UP_PHASE(10, W_UP1)
    DN_PHASE(11, W_DN1, 2)
#undef IN
#undef BOTH
}

extern "C" void kernel_launch(void* const* d_in, const int* in_sizes, int n_in, void* d_out, int out_size, void* d_ws, size_t ws_size, hipStream_t stream) {
    static int grid = 0;
    if (grid == 0) {
        if (n_in != 14 || in_sizes[0] != MTOK * DM || out_size != MTOK * DM || ws_size < WS_END) { fprintf(stderr, "kernel_launch: unexpected shapes (n_in %d, in0 %d, out %d, ws %zu); nothing launched\n", n_in, n_in > 0 ? in_sizes[0] : -1, out_size, ws_size); grid = -1; return; }
        int dev = 0, cus = 0, per_cu = 0;
        if (hipGetDevice(&dev) != hipSuccess || hipDeviceGetAttribute(&cus, hipDeviceAttributeMultiprocessorCount, dev) != hipSuccess) { fprintf(stderr, "kernel_launch: device query failed\n"); grid = -1; return; }
        if (hipFuncSetAttribute((const void*)hybrid_fwd, hipFuncAttributeMaxDynamicSharedMemorySize, LDS_BYTES) != hipSuccess) { fprintf(stderr, "kernel_launch: hipFuncSetAttribute failed\n"); grid = -1; return; }
        if (hipOccupancyMaxActiveBlocksPerMultiprocessor(&per_cu, (const void*)hybrid_fwd, NWAVES * 64, LDS_BYTES) != hipSuccess || per_cu < 1) fprintf(stderr, "kernel_launch: note: occupancy query reports %d workgroups per CU\n", per_cu);
        (void)hipGetLastError();
        grid = cus;
        if (grid != 256) { fprintf(stderr, "kernel_launch: built for a 256-CU device, found %d CUs; nothing launched\n", cus); grid = -1; return; }
    }
    if (grid < 0) return;
    if (hipMemsetAsync((char*)d_ws + WS_CTL, 0, CTL_ZERO_BYTES, stream) != hipSuccess) { fprintf(stderr, "kernel_launch: hipMemsetAsync failed\n"); return; }
    Args a{};
    for (int i = 0; i < 14; ++i) a.in[i] = (const float*)d_in[i];
    a.out = (float*)d_out; a.ws = (unsigned char*)d_ws;
    if (N_LAUNCHES == 1) { a.ph_lo = 0; a.ph_hi = PER_PHASE; a.li = 0; hipLaunchKernelGGL(hybrid_fwd, dim3(grid), dim3(NWAVES * 64), LDS_BYTES, stream, a); }
    else for (int li = 0; li < PER_PHASE; ++li) { a.ph_lo = li; a.ph_hi = li + 1; a.li = li; hipLaunchKernelGGL(hybrid_fwd, dim3(grid), dim3(NWAVES * 64), LDS_BYTES, stream, a); }
    const hipError_t le = hipPeekAtLastError();
    if (le != hipSuccess) fprintf(stderr, "kernel_launch: launch failed: %s\n", hipGetErrorName(le));
}
```

```cpp
#include <hip/hip_runtime.h>
#include <cstdio>
#include <cstdint>

#define LAS __attribute__((address_space(3)))
#define GAS __attribute__((address_space(1)))
typedef unsigned short bf16_t;
typedef short bf16x8 __attribute__((ext_vector_type(8)));
typedef short s16x4 __attribute__((ext_vector_type(4)));
typedef float f32x4 __attribute__((ext_vector_type(4)));
typedef float f32x2 __attribute__((ext_vector_type(2)));
typedef float f32x16 __attribute__((ext_vector_type(16)));
typedef unsigned u32x4 __attribute__((ext_vector_type(4)));
typedef unsigned u32x2 __attribute__((ext_vector_type(2)));
typedef __bf16 bf16x2_t __attribute__((ext_vector_type(2)));

constexpr int BATCH = 4, SEQ = 4096, DM = 1024, MTOK = BATCH * SEQ, FF = 4096, HD = 64;
constexpr int NQKV0 = 4608, NO0 = 512, NQKV1 = 3072, NO1 = 1024;
constexpr float EPS = 1e-6f, LOG2E = 1.4426950408889634f, QSCALE = 0.125f * LOG2E, NEGV = -1e30f;
constexpr int TBLB_N = 4352, TBLA_N = 640, TOFF = 255;

__device__ __forceinline__ unsigned cvtpk(float lo, float hi) { f32x2 v = {lo, hi}; bf16x2_t b = __builtin_convertvector(v, bf16x2_t); return __builtin_bit_cast(unsigned, b); }
__device__ __forceinline__ float bf2f(unsigned short h) { return __builtin_bit_cast(float, (unsigned)h << 16); }
__device__ __forceinline__ float rsq(float x) { return __builtin_amdgcn_rsqf(x); }

namespace pg8 {
constexpr int BM = 256, BK = 64, HALF = 128, HTB = HALF * BK * 2, STAGE_BYTES = 8 * HTB, NXCD = 8, WGM = 4;
__host__ __device__ __forceinline__ int lds_byte(int r, int c) { const int st = (r >> 4) * 2 + (c >> 5), rr = r & 15, cc = c & 31, ob = rr * 64 + cc * 2; return st * 1024 + (ob ^ (((ob >> 9) & 1) << 5)); }
__host__ __device__ __forceinline__ void stage_rc(int b, int& R, int& C) { const int st = b / 1024, sb = b % 1024, swz = sb ^ (((sb >> 9) & 1) << 5); R = (st >> 1) * 16 + swz / 64; C = (st & 1) * 32 + (swz % 64) / 2; }
__host__ __device__ __forceinline__ int perm32(int rho) { const int n = rho >> 4, i = rho & 15; return 8 * (i >> 2) + 4 * n + (i & 3); }
struct Unit { int pm, pn; };
struct Gemm { const bf16_t* A; const bf16_t* Bt; int M, N, K; };
struct StaticOrder {
    int nM, nN, nwg, G, c;
    __host__ __device__ void init(int M, int N, int G_, int c_) { nM = M / BM; nN = N / BM; nwg = nM * nN; G = G_; c = c_; }
    __host__ __device__ bool next(int i, Unit& u) const {
        const long L = (long)i * G + c; if (L >= nwg) return false;
        int wgid = (int)L; { const int q = nwg / NXCD, r = nwg % NXCD, xcd = wgid % NXCD, off = wgid / NXCD; wgid = (xcd < r ? xcd * (q + 1) : r * (q + 1) + (xcd - r) * q) + off; }
        const int nig = WGM * nN, gid = wgid / nig, fm = gid * WGM, gsz = (nM - fm) < WGM ? (nM - fm) : WGM;
        u.pm = fm + ((wgid % nig) % gsz); u.pn = (wgid % nig) / gsz; return true;
    }
};

struct EpiQKV {
    static constexpr bool PERM = true, AFTER_DRAIN = false;
    int layer; const float* ssp; const float* gq; const float* gk; bf16_t* dst; float* kmp;
    __device__ __forceinline__ void operator()(const f32x4 (&acc)[2][2][4][2], const Unit& u, int wr, int wc, int fr, int fq) const {
        const int pn = u.pn, pm = u.pm; int kind, hh, g = 0;
        if (layer == 0) { kind = pn / 6; const int rem = pn % 6; g = rem >> 1; hh = (rem & 1) * 4 + wc; } else { kind = pn >> 2; hh = (pn & 3) * 4 + wc; }
        f32x4 gv[2][2]; const float* gp = (kind == 0) ? gq : gk;
#pragma unroll
        for (int bj = 0; bj < 2; ++bj)
#pragma unroll
            for (int n = 0; n < 2; ++n) gv[bj][n] = *(const f32x4*)(gp + 32 * bj + 8 * fq + 4 * n);
        f32x4 cs[2][2];
#pragma unroll
        for (int bj = 0; bj < 2; ++bj)
#pragma unroll
            for (int n = 0; n < 2; ++n) cs[bj][n] = (f32x4){0.f, 0.f, 0.f, 0.f};
        const bool km = (layer == 1 && kind == 1);
#pragma unroll
        for (int ai = 0; ai < 2; ++ai)
#pragma unroll
            for (int m = 0; m < 4; ++m) {
                const int row = pm * BM + ai * HALF + wr * 64 + m * 16 + fr;
                const f32x4 pv = *(const f32x4*)(ssp + (size_t)row * 4);
                const float r = rsq(((pv[0] + pv[1]) + (pv[2] + pv[3])) * (1.f / 1024.f) + EPS);
                f32x4 v[2][2];
#pragma unroll
                for (int bj = 0; bj < 2; ++bj)
#pragma unroll
                    for (int n = 0; n < 2; ++n) v[bj][n] = acc[ai][bj][m][n] * r;
                if (kind < 2) {
                    float s = 0.f;
#pragma unroll
                    for (int bj = 0; bj < 2; ++bj)
#pragma unroll
                        for (int n = 0; n < 2; ++n) { const f32x4 x = v[bj][n]; s += (x[0] * x[0] + x[1] * x[1]) + (x[2] * x[2] + x[3] * x[3]); }
                    s += __shfl_xor(s, 16); s += __shfl_xor(s, 32);
                    float rn = rsq(s * (1.f / 64.f) + EPS); if (kind == 0) rn *= QSCALE;
#pragma unroll
                    for (int bj = 0; bj < 2; ++bj)
#pragma unroll
                        for (int n = 0; n < 2; ++n) { v[bj][n] = v[bj][n] * rn * gv[bj][n]; if (km) cs[bj][n] += v[bj][n]; }
                }
                const int b = row >> 12, t = row & 4095; size_t off;
                if (layer == 0) { const int sh = 2 * g, c = t & ((1 << sh) - 1), l = t >> sh;
                    off = (size_t)(kind * 3 + g) * ((size_t)MTOK * 512) + ((((size_t)((b << sh) + c)) * 8 + hh) * (size_t)(4096 >> sh) + l) * 64; }
                else off = (size_t)kind * ((size_t)MTOK * 1024) + (((size_t)b * 16 + hh) * 4096 + t) * 64;
                bf16_t* p = dst + off + 8 * fq;
#pragma unroll
                for (int bj = 0; bj < 2; ++bj) { u32x4 w; w.x = cvtpk(v[bj][0][0], v[bj][0][1]); w.y = cvtpk(v[bj][0][2], v[bj][0][3]); w.z = cvtpk(v[bj][1][0], v[bj][1][1]); w.w = cvtpk(v[bj][1][2], v[bj][1][3]);
                    *(u32x4*)(p + 32 * bj) = w; }
            }
        if (km) {
#pragma unroll
            for (int bj = 0; bj < 2; ++bj)
#pragma unroll
                for (int n = 0; n < 2; ++n)
#pragma unroll
                    for (int e = 0; e < 4; ++e) { float x = cs[bj][n][e]; x += __shfl_xor(x, 1); x += __shfl_xor(x, 2); x += __shfl_xor(x, 4); x += __shfl_xor(x, 8); cs[bj][n][e] = x; }
            if (fr == 0) { const int b = pm >> 4, nb = pm & 15; float* kp = kmp + ((((size_t)wr * BATCH + b) * 16 + nb) * 16 + hh) * 64 + 8 * fq;
#pragma unroll
                for (int bj = 0; bj < 2; ++bj)
#pragma unroll
                    for (int n = 0; n < 2; ++n) *(f32x4*)(kp + 32 * bj + 4 * n) = cs[bj][n]; }
        }
    }
};
struct EpiUp {
    static constexpr bool PERM = true, AFTER_DRAIN = false;
    const float* ssp; bf16_t* H;
    __device__ __forceinline__ void operator()(const f32x4 (&acc)[2][2][4][2], const Unit& u, int wr, int wc, int fr, int fq) const {
#pragma unroll
        for (int ai = 0; ai < 2; ++ai)
#pragma unroll
            for (int m = 0; m < 4; ++m) {
                const int row = u.pm * BM + ai * HALF + wr * 64 + m * 16 + fr;
                const f32x4 pv = *(const f32x4*)(ssp + (size_t)row * 4);
                const float r = rsq(((pv[0] + pv[1]) + (pv[2] + pv[3])) * (1.f / 1024.f) + EPS);
                bf16_t* rowp = H + (size_t)row * FF + u.pn * BM + wc * 32 + 8 * fq;
#pragma unroll
                for (int bj = 0; bj < 2; ++bj) { f32x4 v0 = acc[ai][bj][m][0] * r, v1 = acc[ai][bj][m][1] * r;
#pragma unroll
                    for (int e = 0; e < 4; ++e) { const float a = fmaxf(v0[e], 0.f), b = fmaxf(v1[e], 0.f); v0[e] = a * a; v1[e] = b * b; }
                    u32x4 w; w.x = cvtpk(v0[0], v0[1]); w.y = cvtpk(v0[2], v0[3]); w.z = cvtpk(v1[0], v1[1]); w.w = cvtpk(v1[2], v1[3]);
                    *(u32x4*)(rowp + bj * HALF) = w; }
            }
    }
};
template <int MODE> struct EpiRes {
    static constexpr bool PERM = true, AFTER_DRAIN = true;
    const float* basef; float* out; bf16_t* hb; float* ssp;
    __device__ __forceinline__ void fused(f32x4 (&acc)[2][2][4][2], const Unit& u, int wr, int wc, int fr, int fq, LAS unsigned char* lds, int wid, int lane) const {
        LAS float* P = (LAS float*)lds;
        const int col0 = u.pn * BM + wc * 32 + 8 * fq;
#pragma unroll
        for (int ai = 0; ai < 2; ++ai)
#pragma unroll
            for (int m = 0; m < 4; ++m) {
                const int rl = ai * HALF + wr * 64 + m * 16 + fr; const size_t off = (size_t)(u.pm * BM + rl) * DM + col0; float s = 0.f;
                f32x4 bv[2][2];
#pragma unroll
                for (int bj = 0; bj < 2; ++bj) {
                    if (MODE == 0) { bv[bj][0] = *(const f32x4*)(basef + off + bj * HALF); bv[bj][1] = *(const f32x4*)(basef + off + bj * HALF + 4); }
                    else { const u32x4 w = *(const u32x4*)(hb + off + bj * HALF);
                        bv[bj][0] = (f32x4){__builtin_bit_cast(float, w.x << 16), __builtin_bit_cast(float, w.x & 0xffff0000u), __builtin_bit_cast(float, w.y << 16), __builtin_bit_cast(float, w.y & 0xffff0000u)};
                        bv[bj][1] = (f32x4){__builtin_bit_cast(float, w.z << 16), __builtin_bit_cast(float, w.z & 0xffff0000u), __builtin_bit_cast(float, w.w << 16), __builtin_bit_cast(float, w.w & 0xffff0000u)}; } }
#pragma unroll
                for (int bj = 0; bj < 2; ++bj) { const f32x4 h0 = bv[bj][0] + acc[ai][bj][m][0], h1 = bv[bj][1] + acc[ai][bj][m][1];
                    if (MODE == 2) { *(f32x4*)(out + off + bj * HALF) = h0; *(f32x4*)(out + off + bj * HALF + 4) = h1; }
                    else { u32x4 w; w.x = cvtpk(h0[0], h0[1]); w.y = cvtpk(h0[2], h0[3]); w.z = cvtpk(h1[0], h1[1]); w.w = cvtpk(h1[2], h1[3]); *(u32x4*)(hb + off + bj * HALF) = w;
                        s += ((h0[0] * h0[0] + h0[1] * h0[1]) + (h0[2] * h0[2] + h0[3] * h0[3])) + ((h1[0] * h1[0] + h1[1] * h1[1]) + (h1[2] * h1[2] + h1[3] * h1[3])); } }
                if (MODE != 2) { s += __shfl_xor(s, 16); s += __shfl_xor(s, 32); if (fq == 0) P[rl * 4 + wc] = s; }
                asm volatile("" ::: "memory");
            }
        if (MODE != 2) {
            asm volatile("s_waitcnt lgkmcnt(0)" ::: "memory"); __builtin_amdgcn_s_barrier(); asm volatile("" ::: "memory");
            const int t = wid * 64 + lane;
            if (t < 256) { const f32x4 p = *(const LAS f32x4*)(P + t * 4); ssp[(size_t)(u.pm * BM + t) * 4 + u.pn] = (p[0] + p[1]) + (p[2] + p[3]); }
        }
    }
};

template <class Epi, class Sched, bool ALIGN_EPI = false, bool SP2 = false>
__device__ __forceinline__ void gemm_phase(LAS unsigned char* lds, const Gemm g, const Sched& S, const Epi& E) {
    const int tid = threadIdx.x, wid = __builtin_amdgcn_readfirstlane(tid >> 6), lane = tid & 63, wr = wid >> 2, wc = wid & 3, fr = lane & 15, fq = lane >> 4;
    const int K = g.K, nt = K / BK;
    unsigned voffA[2], voffB[2];
#pragma unroll
    for (int i = 0; i < 2; ++i) { int R, C; stage_rc(tid * 16 + i * 8192, R, C); const int Rb = Epi::PERM ? ((R & ~31) + perm32(R & 31)) : R;
        voffA[i] = (unsigned)(R * K + C) * 2u; voffB[i] = (unsigned)(Rb * K + C) * 2u; }
    const size_t kstep = (size_t)(BK * 2);
    const size_t hstep = (size_t)HALF * K * 2;
    const size_t tstep = 2 * hstep;
    const unsigned ldsw = (unsigned)wid * 1024u;
    const int aoff = lds_byte(wr * 64 + fr, fq * 8), boff = lds_byte(wc * 32 + fr, fq * 8);
#define PG8_SA(b, h) (((b) * 2 + (h)) * HTB)
#define PG8_SB(b, h) ((4 + (b) * 2 + (h)) * HTB)
#define PG8_STAGE(bufoff, gbase, voff) do { _Pragma("unroll") for (int _i = 0; _i < 2; ++_i) \
        __builtin_amdgcn_global_load_lds((const unsigned*)((const char*)(gbase) + (voff)[_i]), (LAS unsigned*)(lds + (bufoff) + ldsw + _i * 8192), 16, 0, 0); } while (0)
#define PG8_LDA(dst, b, h) do { _Pragma("unroll") for (int m = 0; m < 4; ++m) _Pragma("unroll") for (int k = 0; k < 2; ++k) dst[m][k] = *(const LAS bf16x8*)(lds + PG8_SA(b, h) + aoff + m * 2048 + k * 1024); } while (0)
#define PG8_LDB(dst, b, h) do { _Pragma("unroll") for (int n = 0; n < 2; ++n) _Pragma("unroll") for (int k = 0; k < 2; ++k) dst[n][k] = *(const LAS bf16x8*)(lds + PG8_SB(b, h) + boff + n * 2048 + k * 1024); } while (0)
#define PG8_MMA(ai, bj, At, Bt) do { __builtin_amdgcn_s_setprio(1); _Pragma("unroll") for (int m = 0; m < 4; ++m) _Pragma("unroll") for (int n = 0; n < 2; ++n) _Pragma("unroll") for (int k = 0; k < 2; ++k) \
        acc[ai][bj][m][n] = __builtin_amdgcn_mfma_f32_16x16x32_bf16(Bt[n][k], At[m][k], acc[ai][bj][m][n], 0, 0, 0); __builtin_amdgcn_s_setprio(0); } while (0)
#define PG8_WAIT_V(n) asm volatile("s_waitcnt vmcnt(" #n ")" ::: "memory")
#define PG8_WAIT_L(n) asm volatile("s_waitcnt lgkmcnt(" #n ")" ::: "memory")
#define PG8_BAR __builtin_amdgcn_s_barrier()
#define PG8_SCHED __builtin_amdgcn_sched_barrier(0)
    Unit cur, nxt; int ui = 0;
    if (!S.next(0, cur)) return;
    f32x4 acc[2][2][4][2];
#pragma unroll
    for (int a = 0; a < 2; ++a)
#pragma unroll
        for (int b = 0; b < 2; ++b)
#pragma unroll
            for (int m = 0; m < 4; ++m)
#pragma unroll
                for (int n = 0; n < 2; ++n) acc[a][b][m][n] = (f32x4){0.f, 0.f, 0.f, 0.f};
    bf16x8 At[4][2], B0[2][2], B1[2][2];
    const char* cA = (const char*)g.A + (size_t)cur.pm * tstep; const char* cB = (const char*)g.Bt + (size_t)cur.pn * tstep;
    if constexpr (SP2) {
        PG8_STAGE(PG8_SB(0, 0), cB, voffB); PG8_STAGE(PG8_SB(0, 1), cB + hstep, voffB); PG8_STAGE(PG8_SA(0, 0), cA, voffA); PG8_STAGE(PG8_SA(0, 1), cA + hstep, voffA);
        if (wr == 1) PG8_BAR;
        PG8_WAIT_V(2); PG8_BAR;
        PG8_STAGE(PG8_SB(1, 0), cB + kstep, voffB); PG8_STAGE(PG8_SA(1, 0), cA + kstep, voffA); PG8_STAGE(PG8_SB(1, 1), cB + hstep + kstep, voffB);
        PG8_WAIT_V(6); PG8_BAR;
    } else {
        PG8_STAGE(PG8_SB(0, 0), cB, voffB); PG8_STAGE(PG8_SA(0, 0), cA, voffA); PG8_STAGE(PG8_SB(0, 1), cB + hstep, voffB); PG8_STAGE(PG8_SA(0, 1), cA + hstep, voffA);
        if (wr == 1) PG8_BAR;
        PG8_WAIT_V(4); PG8_BAR;
        PG8_STAGE(PG8_SB(1, 0), cB + kstep, voffB); PG8_STAGE(PG8_SA(1, 0), cA + kstep, voffA); PG8_STAGE(PG8_SB(1, 1), cB + hstep + kstep, voffB);
        PG8_WAIT_V(6); PG8_BAR;
    }
    for (;;) {
        const bool has_next = S.next(ui + 1, nxt);
        const char* nA = has_next ? (const char*)g.A + (size_t)nxt.pm * tstep : cA; const char* nB = has_next ? (const char*)g.Bt + (size_t)nxt.pn * tstep : cB;
        for (int t = 0; t < nt; t += 2) {
            const bool last = (t == nt - 2);
            const char* a1 = cA + (size_t)(t + 1) * kstep;
            const char* a2 = last ? nA : cA + (size_t)(t + 2) * kstep; const char* b2 = last ? nB : cB + (size_t)(t + 2) * kstep;
            const char* a3 = a2 + kstep; const char* b3 = b2 + kstep;
            if constexpr (SP2) {
            PG8_LDB(B0, 0, 0); PG8_LDB(B1, 0, 1); PG8_SCHED; PG8_LDA(At, 0, 0); PG8_STAGE(PG8_SA(1, 1), a1 + hstep, voffA);
            PG8_WAIT_V(8); PG8_WAIT_L(0); PG8_BAR; PG8_MMA(0, 0, At, B0); PG8_MMA(0, 1, At, B1); PG8_BAR; PG8_SCHED;
            PG8_LDA(At, 0, 1); PG8_STAGE(PG8_SB(0, 0), b2, voffB); PG8_STAGE(PG8_SB(0, 1), b2 + hstep, voffB); PG8_STAGE(PG8_SA(0, 0), a2, voffA);
            PG8_WAIT_V(8); PG8_WAIT_L(0); PG8_BAR; PG8_MMA(1, 0, At, B0); PG8_MMA(1, 1, At, B1); PG8_BAR; PG8_SCHED;
            PG8_LDB(B0, 1, 0); PG8_LDB(B1, 1, 1); PG8_SCHED; PG8_LDA(At, 1, 0); PG8_STAGE(PG8_SA(0, 1), a2 + hstep, voffA);
            PG8_WAIT_V(8); PG8_WAIT_L(0); PG8_BAR; PG8_MMA(0, 0, At, B0); PG8_MMA(0, 1, At, B1); PG8_BAR; PG8_SCHED;
            PG8_LDA(At, 1, 1); PG8_STAGE(PG8_SB(1, 0), b3, voffB); PG8_STAGE(PG8_SB(1, 1), b3 + hstep, voffB); PG8_STAGE(PG8_SA(1, 0), a3, voffA);
            PG8_WAIT_V(8); PG8_WAIT_L(0); PG8_BAR; PG8_MMA(1, 0, At, B0); PG8_MMA(1, 1, At, B1); PG8_BAR; PG8_SCHED;
            } else {
            PG8_LDB(B0, 0, 0); PG8_SCHED; PG8_LDA(At, 0, 0); PG8_STAGE(PG8_SA(1, 1), a1 + hstep, voffA);
            PG8_WAIT_L(8); PG8_BAR; PG8_WAIT_L(0); PG8_MMA(0, 0, At, B0); PG8_BAR; PG8_SCHED;
            PG8_LDB(B1, 0, 1); PG8_STAGE(PG8_SB(0, 0), b2, voffB);
            PG8_BAR; PG8_WAIT_L(0); PG8_MMA(0, 1, At, B1); PG8_BAR;
            PG8_LDA(At, 0, 1); PG8_STAGE(PG8_SA(0, 0), a2, voffA);
            PG8_BAR; PG8_WAIT_L(0); PG8_MMA(1, 0, At, B0); PG8_BAR; PG8_SCHED;
            PG8_STAGE(PG8_SB(0, 1), b2 + hstep, voffB);
            PG8_WAIT_V(6); PG8_BAR; PG8_MMA(1, 1, At, B1); PG8_BAR;
            PG8_LDB(B0, 1, 0); PG8_SCHED; PG8_LDA(At, 1, 0); PG8_STAGE(PG8_SA(0, 1), a2 + hstep, voffA);
            PG8_WAIT_L(8); PG8_BAR; PG8_WAIT_L(0); PG8_MMA(0, 0, At, B0); PG8_BAR; PG8_SCHED;
            PG8_LDB(B1, 1, 1); PG8_STAGE(PG8_SB(1, 0), b3, voffB);
            PG8_BAR; PG8_WAIT_L(0); PG8_MMA(0, 1, At, B1); PG8_BAR;
            PG8_LDA(At, 1, 1); PG8_STAGE(PG8_SA(1, 0), a3, voffA);
            PG8_BAR; PG8_WAIT_L(0); PG8_MMA(1, 0, At, B0); PG8_BAR; PG8_SCHED;
            PG8_STAGE(PG8_SB(1, 1), b3 + hstep, voffB);
            PG8_WAIT_V(6); PG8_BAR; PG8_MMA(1, 1, At, B1); PG8_BAR;
            }
        }
        if constexpr (ALIGN_EPI) { if (wr == 0) PG8_BAR; }
        if constexpr (!Epi::AFTER_DRAIN) { E(acc, cur, wr, wc, fr, fq); }
        if (!has_next) break;
#pragma unroll
        for (int a = 0; a < 2; ++a)
#pragma unroll
            for (int b = 0; b < 2; ++b)
#pragma unroll
                for (int m = 0; m < 4; ++m)
#pragma unroll
                    for (int n = 0; n < 2; ++n) acc[a][b][m][n] = (f32x4){0.f, 0.f, 0.f, 0.f};
        cur = nxt; cA = nA; cB = nB; ++ui;
        if constexpr (ALIGN_EPI) { if (wr == 1) PG8_BAR; }
    }
    PG8_WAIT_V(0);
    if constexpr (!ALIGN_EPI) { if (wr == 0) PG8_BAR; }
    PG8_BAR;
    if constexpr (Epi::AFTER_DRAIN) { E.fused(acc, cur, wr, wc, fr, fq, lds, wid, lane); }
#undef PG8_SA
#undef PG8_SB
#undef PG8_STAGE
#undef PG8_LDA
#undef PG8_LDB
#undef PG8_MMA
#undef PG8_WAIT_V
#undef PG8_WAIT_L
#undef PG8_BAR
#undef PG8_SCHED
}
}

namespace att {
constexpr int KB_OFF = 0, VB_OFF = 32768, TBL_OFF = 65536, OST_OFF = 68608, WS_OFF = OST_OFF + 8 * 4096, LDS_END = WS_OFF + 8 * 128;
__device__ __forceinline__ int crow(int r, int hi) { return (r & 3) + 8 * (r >> 2) + 4 * hi; }
#define ATT_WAIT_BAR() asm volatile("s_waitcnt vmcnt(0) lgkmcnt(0)\n\ts_barrier" ::: "memory")
__device__ __forceinline__ void glds16(const void* gsrc, unsigned lds_dst) { unsigned keep;
    asm volatile("s_mov_b32 %0, m0\n\ts_mov_b32 m0, %2\n\ts_nop 0\n\tglobal_load_lds_dwordx4 %1, off\n\ts_mov_b32 m0, %0" : "=&s"(keep) : "v"(gsrc), "s"(lds_dst) : "memory"); }

struct StreamDesc {
    const bf16_t* Q; const bf16_t* K; const bf16_t* V;
    int i0, R;
    const float* tblg;
    bf16_t* O; int o_row0, o_rstride;
    float* L;
};
constexpr int S_KB = 0, S_VB = 49152, S_TBL = 98304, S_OST = 101376, S_WS = S_OST + 8 * 4096, S_END = S_WS + 8 * 128;
__device__ __forceinline__ void stream(LAS unsigned char* lds, const StreamDesc& U) {
    const int tid = threadIdx.x, lane = tid & 63, r32 = lane & 31, hi = lane >> 5; const int wid = __builtin_amdgcn_readfirstlane(tid >> 6);
    LAS float* tbl = (LAS float*)(lds + S_TBL);
    { int t_ = tid; asm volatile("" : "+v"(t_));
      for (int i = t_; i < TBLA_N / 4; i += 512) ((LAS f32x4*)tbl)[i] = ((const f32x4*)U.tblg)[i]; }
    const unsigned lds0 = (unsigned)(uintptr_t)lds;
#define ATT_DMA(t) do { int l_ = lane; asm volatile("" : "+v"(l_)); const int sl_ = (t) % 6; \
        glds16(U.K + (size_t)l_ * 64 + wid * 8 + (size_t)(t) * 4096, (unsigned)__builtin_amdgcn_readfirstlane((int)(lds0 + S_KB + sl_ * 8192 + wid * 1024))); \
        glds16(U.V + (size_t)(16 * (wid & 3) + (l_ >> 2)) * 64 + (wid >> 2) * 32 + (l_ & 3) * 8 + (size_t)(t) * 4096, (unsigned)__builtin_amdgcn_readfirstlane((int)(lds0 + S_VB + sl_ * 8192 + wid * 1024))); } while (0)
    const int t_first = (U.i0 >> 1) - 2 > 0 ? (U.i0 >> 1) - 2 : 0, t_last = (U.i0 >> 1) + 4 * U.R - 1;
    int r = 0;
    int qt = U.i0 + wid;
    bf16x8 qr[4], qn[4];
#pragma unroll
    for (int d0 = 0; d0 < 4; ++d0) { qr[d0] = *(const bf16x8*)(U.Q + (size_t)(qt * 32 + r32) * 64 + d0 * 16 + hi * 8);
        qn[d0] = *(const bf16x8*)(U.Q + (size_t)((U.R > 1 ? qt + 8 : qt) * 32 + r32) * 64 + d0 * 16 + hi * 8); }
    ATT_DMA(t_first); ATT_DMA(t_first + 1);
    f32x16 o[2], ol; o[0] = (f32x16){0.f, 0.f, 0.f, 0.f, 0.f, 0.f, 0.f, 0.f, 0.f, 0.f, 0.f, 0.f, 0.f, 0.f, 0.f, 0.f}; o[1] = o[0]; ol = o[0];
    const int vb0 = (int)(unsigned)(uintptr_t)(lds + S_VB) + ((lane >> 4) & 1) * 32 + (lane & 3) * 8 + (4 * hi + ((lane & 15) >> 2)) * 64;
    const bf16x8 ones = {0x3F80, 0x3F80, 0x3F80, 0x3F80, 0x3F80, 0x3F80, 0x3F80, 0x3F80};
    LAS bf16_t* stg = (LAS bf16_t*)(lds + S_OST) + wid * 2048;
    LAS float* wsl = (LAS float*)(lds + S_WS) + wid * 32;
    ATT_WAIT_BAR();
#define ST_TILEH(tt, H0, H1) do { const int kbase_ = (tt) * 64, qrow_ = qt * 32 + r32, sl_ = (tt) % 6; \
        const LAS float* tp_ = tbl + (383 - (qrow_ - kbase_) + 4 * hi); f32x16 p0, p1; \
        _Pragma("unroll") for (int rr = 0; rr < 16; ++rr) { const int cc = (rr & 3) + 8 * (rr >> 2); if (H0) p0[rr] = tp_[cc]; if (H1) p1[rr] = tp_[cc + 32]; } \
        const LAS unsigned char* kb_ = lds + S_KB + sl_ * 8192 + hi * 1024 + r32 * 16; \
        _Pragma("unroll") for (int d0 = 0; d0 < 4; ++d0) { \
            if (H0) { const bf16x8 kf0_ = *(const LAS bf16x8*)(kb_ + d0 * 2048); p0 = __builtin_amdgcn_mfma_f32_32x32x16_bf16(kf0_, qr[d0], p0, 0, 0, 0); } \
            if (H1) { const bf16x8 kf1_ = *(const LAS bf16x8*)(kb_ + d0 * 2048 + 512); p1 = __builtin_amdgcn_mfma_f32_32x32x16_bf16(kf1_, qr[d0], p1, 0, 0, 0); } } \
        _Pragma("unroll") for (int rr = 0; rr < 16; ++rr) { if (H0) p0[rr] = __builtin_amdgcn_exp2f(p0[rr]); if (H1) p1[rr] = __builtin_amdgcn_exp2f(p1[rr]); } \
        u32x4 pw[4]; \
        _Pragma("unroll") for (int k = 0; k < 2; ++k) { \
            if (H0) pw[k] = (u32x4){cvtpk(p0[8 * k], p0[8 * k + 1]), cvtpk(p0[8 * k + 2], p0[8 * k + 3]), cvtpk(p0[8 * k + 4], p0[8 * k + 5]), cvtpk(p0[8 * k + 6], p0[8 * k + 7])}; \
            if (H1) pw[2 + k] = (u32x4){cvtpk(p1[8 * k], p1[8 * k + 1]), cvtpk(p1[8 * k + 2], p1[8 * k + 3]), cvtpk(p1[8 * k + 4], p1[8 * k + 5]), cvtpk(p1[8 * k + 6], p1[8 * k + 7])}; } \
        _Pragma("unroll") for (int ks = (H0) ? 0 : 2; ks < ((H1) ? 4 : 2); ++ks) ol = __builtin_amdgcn_mfma_f32_32x32x16_bf16(__builtin_bit_cast(bf16x8, pw[ks]), ones, ol, 0, 0, 0); \
        const int vb_ = vb0 + sl_ * 8192; \
        _Pragma("unroll") for (int d0 = 0; d0 < 2; ++d0) { s16x4 vlo[4], vhi[4]; \
            _Pragma("unroll") for (int ks = (H0) ? 0 : 2; ks < ((H1) ? 4 : 2); ++ks) { vlo[ks] = __builtin_bit_cast(s16x4, __builtin_amdgcn_ds_read_tr16_b64_v4i16((LAS s16x4*)(uintptr_t)(unsigned)(vb_ + d0 * 4096 + ks * 1024))); \
                                                             vhi[ks] = __builtin_bit_cast(s16x4, __builtin_amdgcn_ds_read_tr16_b64_v4i16((LAS s16x4*)(uintptr_t)(unsigned)(vb_ + d0 * 4096 + ks * 1024 + 512))); } \
            _Pragma("unroll") for (int ks = (H0) ? 0 : 2; ks < ((H1) ? 4 : 2); ++ks) { const bf16x8 vf = (bf16x8){vlo[ks][0], vlo[ks][1], vlo[ks][2], vlo[ks][3], vhi[ks][0], vhi[ks][1], vhi[ks][2], vhi[ks][3]}; \
                o[d0] = __builtin_amdgcn_mfma_f32_32x32x16_bf16(__builtin_bit_cast(bf16x8, pw[ks]), vf, o[d0], 0, 0, 0); } } } while (0)
#define ST_TILE(tt) ST_TILEH(tt, true, true)
    int pend_qt = -1;
#define ST_FLUSH() do { if (pend_qt >= 0) { \
        { const float lv = wsl[r32]; float* lp = U.L + (size_t)(U.o_row0 + (pend_qt * 32 + r32) * U.o_rstride) * 8; if (hi == 0) *lp = lv; } \
        _Pragma("unroll") for (int i = 0; i < 4; ++i) { const int row = i * 8 + (lane >> 3), ch = lane & 7; const u32x4 v = *(const LAS u32x4*)(stg + row * 64 + ch * 8); \
            *(u32x4*)(U.O + (size_t)(U.o_row0 + (pend_qt * 32 + row) * U.o_rstride) * 512 + ch * 8) = v; } \
        if (r + 1 < U.R) { _Pragma("unroll") for (int d0 = 0; d0 < 4; ++d0) qn[d0] = *(const bf16x8*)(U.Q + (size_t)((qt + 8) * 32 + r32) * 64 + d0 * 16 + hi * 8); } \
        pend_qt = -1; } } while (0)
    for (int t = t_first; t < t_last; t += 2) {
        if (t + 2 < t_last) { ATT_DMA(t + 2); ATT_DMA(t + 3); }
        ST_FLUSH();
        if (r < U.R) {
            const int wend = qt >> 1;
            const bool a0 = (t >= wend - 2) && (t <= wend), a1 = (t + 1 >= wend - 2) && (t + 1 <= wend);
            const bool odd = qt & 1;
            if (a0 && a1) {
                if (t == wend - 2) { if (odd) { ST_TILEH(t, false, true); ST_TILE(t + 1); } else { ST_TILE(t); ST_TILE(t + 1); } }
                else { if (!odd) { ST_TILE(t); ST_TILEH(t + 1, true, false); } else { ST_TILE(t); ST_TILE(t + 1); } } }
            else if (a0) { if (!odd && t == wend) ST_TILEH(t, true, false); else ST_TILE(t); }
            else if (a1) { if (odd && t + 1 == wend - 2) ST_TILEH(t + 1, false, true); else ST_TILE(t + 1); }
            if (wend == t || wend == t + 1) {
#pragma unroll
                for (int rr = 0; rr < 16; ++rr) { const int orow = crow(rr, hi);
#pragma unroll
                    for (int d0 = 0; d0 < 2; ++d0) stg[orow * 64 + d0 * 32 + r32] = (bf16_t)(cvtpk(o[d0][rr], 0.f) & 0xffffu);
                    if (r32 == 0) wsl[orow] = ol[rr]; }
                pend_qt = qt; ++r; qt += 8;
                o[0] = (f32x16){0.f, 0.f, 0.f, 0.f, 0.f, 0.f, 0.f, 0.f, 0.f, 0.f, 0.f, 0.f, 0.f, 0.f, 0.f, 0.f}; o[1] = o[0]; ol = o[0];
#pragma unroll
                for (int d0 = 0; d0 < 4; ++d0) qr[d0] = qn[d0];
            }
        }
        ATT_WAIT_BAR();
    }
    ST_FLUSH();
    asm volatile("s_waitcnt vmcnt(0)" ::: "memory");
#undef ST_FLUSH
#undef ATT_DMA
#undef ST_TILE
#undef ST_TILEH
}

constexpr int D_KB = 0, D_VB = 32768, D_TBL = 65536, D_KM = 82944, D_OST = 91136, D_END = D_OST + 8 * 4096;
__device__ __forceinline__ void moba_pair(LAS unsigned char* lds, int p, const bf16_t* Qs, const bf16_t* Ks, const bf16_t* Vs, const float* tblg, const float* kmp0, const float* kmp1, bf16_t* O) {
    const int tid = threadIdx.x, lane = tid & 63, r32 = lane & 31, hi = lane >> 5; const int wid = __builtin_amdgcn_readfirstlane(tid >> 6);
    LAS float* tbl = (LAS float*)(lds + D_TBL);
    const int qbA = 2 * p, qbB = 2 * p + 1, NT = 8 * p + 8, NTA = 8 * p + 4;
    const unsigned lds0 = (unsigned)(uintptr_t)lds;
#define MD_DMA(t) do { int l_ = lane; asm volatile("" : "+v"(l_)); \
        glds16(Ks + (size_t)l_ * 64 + wid * 8 + (size_t)(t) * 4096, (unsigned)__builtin_amdgcn_readfirstlane((int)(lds0 + D_KB + ((t) & 3) * 8192 + wid * 1024))); \
        glds16(Vs + (size_t)(16 * (wid & 3) + (l_ >> 2)) * 64 + (wid >> 2) * 32 + (l_ & 3) * 8 + (size_t)(t) * 4096, (unsigned)__builtin_amdgcn_readfirstlane((int)(lds0 + D_VB + ((t) & 3) * 8192 + wid * 1024))); } while (0)
    for (int i = tid; i < TBLB_N / 4; i += 512) ((LAS f32x4*)tbl)[i] = ((const f32x4*)tblg)[i];
    {   LAS bf16_t* kmh = (LAS bf16_t*)(lds + D_KM); LAS bf16_t* kml = kmh + 32 * 64;
        for (int i = tid; i < 32 * 64; i += 512) { const int j = i >> 6, d = i & 63; float x = 0.f;
            if (j < qbB) x = (kmp0[(size_t)j * 1024 + d] + kmp1[(size_t)j * 1024 + d]) * (1.f / 256.f);
            const unsigned hb = cvtpk(x, 0.f) & 0xffffu; const float xl = x - bf2f((unsigned short)hb);
            kmh[i] = (bf16_t)hb; kml[i] = (bf16_t)(cvtpk(xl, 0.f) & 0xffffu); } }
    const int qt = (wid < 4) ? wid : 11 - wid;
    const int qrowA = qbA * 256 + qt * 32 + r32, qrowB = qrowA + 256;
    bf16x8 qrA[4], qrB[4];
#pragma unroll
    for (int d0 = 0; d0 < 4; ++d0) { qrA[d0] = *(const bf16x8*)(Qs + (size_t)qrowA * 64 + d0 * 16 + hi * 8); qrB[d0] = *(const bf16x8*)(Qs + (size_t)qrowB * 64 + d0 * 16 + hi * 8); }
    MD_DMA(0); MD_DMA(1);
    ATT_WAIT_BAR();
    MD_DMA(2);
    unsigned selA = 0u, selB = 0u;
#define MD_GATE(SEL, QR, QB) do { f32x16 g0 = {0.f, 0.f, 0.f, 0.f, 0.f, 0.f, 0.f, 0.f, 0.f, 0.f, 0.f, 0.f, 0.f, 0.f, 0.f, 0.f}; \
        const LAS unsigned char* kb_ = lds + D_KM + r32 * 128 + hi * 16; \
        _Pragma("unroll") for (int d0 = 0; d0 < 4; ++d0) { const bf16x8 ah = *(const LAS bf16x8*)(kb_ + d0 * 32), al = *(const LAS bf16x8*)(kb_ + 4096 + d0 * 32); \
            g0 = __builtin_amdgcn_mfma_f32_32x32x16_bf16(ah, QR[d0], g0, 0, 0, 0); g0 = __builtin_amdgcn_mfma_f32_32x32x16_bf16(al, QR[d0], g0, 0, 0, 0); } \
        float gt[16]; \
        _Pragma("unroll") for (int r = 0; r < 8; ++r) { const float mine = g0[r], oth = __shfl_xor(mine, 32); const int jm = (r & 3) + 8 * (r >> 2); gt[jm] = hi ? oth : mine; gt[jm + 4] = hi ? mine : oth; } \
        _Pragma("unroll") for (int rep = 0; rep < 3; ++rep) { float best = -__builtin_inff(); int bi = -1; \
            _Pragma("unroll") for (int j = 0; j < 16; ++j) { const bool ok = (j < (QB)) && !((SEL >> j) & 1u) && (gt[j] > best); if (ok) { best = gt[j]; bi = j; } } \
            if (bi >= 0) SEL |= 1u << bi; } \
        SEL |= 1u << (QB); } while (0)
    MD_GATE(selA, qrA, qbA);
    MD_GATE(selB, qrB, qbB);
    LAS unsigned char* qal = lds + D_OST + wid * 4096 + lane * 16;
#pragma unroll
    for (int d0 = 0; d0 < 4; ++d0) *(LAS bf16x8*)(qal + d0 * 1024) = qrA[d0];
#define QA(d0) (*(const LAS bf16x8*)(qal + (d0) * 1024))
#define QB_(d0) qrB[d0]
    const int vb0 = (int)(unsigned)(uintptr_t)(lds + D_VB) + ((lane >> 4) & 1) * 32 + (lane & 3) * 8 + (4 * hi + ((lane & 15) >> 2)) * 64;
    f32x16 oA[2], oB[2]; float olA = 0.f, olB = 0.f; oA[0] = (f32x16){0.f, 0.f, 0.f, 0.f, 0.f, 0.f, 0.f, 0.f, 0.f, 0.f, 0.f, 0.f, 0.f, 0.f, 0.f, 0.f}; oA[1] = oA[0]; oB[0] = oA[0]; oB[1] = oA[0];
#define MD_QK(P0, P1, SEL, QROW, QR, t) do { const int kb_ = 64 * (t); const bool sel_ = (SEL >> ((t) >> 2)) & 1u; \
        const int base_ = sel_ ? (4095 - (QROW - kb_) + 4 * hi) : (4096 + 4 * hi); const LAS float* tp_ = tbl + base_; \
        _Pragma("unroll") for (int r = 0; r < 16; ++r) { const int cc = (r & 3) + 8 * (r >> 2); P0[r] = tp_[cc]; P1[r] = tp_[cc + 32]; } \
        const LAS unsigned char* kq_ = lds + D_KB + ((t) & 3) * 8192 + hi * 1024 + r32 * 16; \
        _Pragma("unroll") for (int d0 = 0; d0 < 4; ++d0) { const bf16x8 kf0_ = *(const LAS bf16x8*)(kq_ + d0 * 2048), kf1_ = *(const LAS bf16x8*)(kq_ + d0 * 2048 + 512); \
            const bf16x8 qf_ = QR(d0); P0 = __builtin_amdgcn_mfma_f32_32x32x16_bf16(kf0_, qf_, P0, 0, 0, 0); P1 = __builtin_amdgcn_mfma_f32_32x32x16_bf16(kf1_, qf_, P1, 0, 0, 0); } } while (0)
#define MD_EXP(PW, P0, P1, OL) do { float s_ = 0.f; \
        _Pragma("unroll") for (int r = 0; r < 16; ++r) { P0[r] = __builtin_amdgcn_exp2f(P0[r]); P1[r] = __builtin_amdgcn_exp2f(P1[r]); s_ += P0[r] + P1[r]; } OL += s_; \
        _Pragma("unroll") for (int k = 0; k < 2; ++k) { PW[k] = (u32x4){cvtpk(P0[8 * k], P0[8 * k + 1]), cvtpk(P0[8 * k + 2], P0[8 * k + 3]), cvtpk(P0[8 * k + 4], P0[8 * k + 5]), cvtpk(P0[8 * k + 6], P0[8 * k + 7])}; \
            PW[2 + k] = (u32x4){cvtpk(P1[8 * k], P1[8 * k + 1]), cvtpk(P1[8 * k + 2], P1[8 * k + 3]), cvtpk(P1[8 * k + 4], P1[8 * k + 5]), cvtpk(P1[8 * k + 6], P1[8 * k + 7])}; } } while (0)
#define MD_PV(OO, PW, t) do { const int vb_ = vb0 + ((t) & 3) * 8192; \
        _Pragma("unroll") for (int d0 = 0; d0 < 2; ++d0) { s16x4 vlo[4], vhi[4]; \
            _Pragma("unroll") for (int ks = 0; ks < 4; ++ks) { vlo[ks] = __builtin_bit_cast(s16x4, __builtin_amdgcn_ds_read_tr16_b64_v4i16((LAS s16x4*)(uintptr_t)(unsigned)(vb_ + d0 * 4096 + ks * 1024))); \
                                                             vhi[ks] = __builtin_bit_cast(s16x4, __builtin_amdgcn_ds_read_tr16_b64_v4i16((LAS s16x4*)(uintptr_t)(unsigned)(vb_ + d0 * 4096 + ks * 1024 + 512))); } \
            _Pragma("unroll") for (int ks = 0; ks < 4; ++ks) { const bf16x8 vf = (bf16x8){vlo[ks][0], vlo[ks][1], vlo[ks][2], vlo[ks][3], vhi[ks][0], vhi[ks][1], vhi[ks][2], vhi[ks][3]}; \
                OO[d0] = __builtin_amdgcn_mfma_f32_32x32x16_bf16(__builtin_bit_cast(bf16x8, PW[ks]), vf, OO[d0], 0, 0, 0); } } } while (0)
#define MD_SB() __builtin_amdgcn_sched_barrier(0)
    for (int t = 0; t < NT; ++t) {
        const bool dma = (t + 3 < NT);
        if (dma) MD_DMA(t + 3);
        const bool needA = (t < NTA) && (t - 8 * p <= (qt >> 1)), needB = (t < NTA) || (t - NTA <= (qt >> 1));
        if (needA) {
            f32x16 a0, a1, b0, b1; u32x4 pwa[4], pwb[4];
            { const int kb_ = 64 * t; const bool sa_ = (selA >> (t >> 2)) & 1u, sb_ = (selB >> (t >> 2)) & 1u;
              const LAS float* ta_ = tbl + (sa_ ? (4095 - (qrowA - kb_) + 4 * hi) : (4096 + 4 * hi)); const LAS float* tb_ = tbl + (sb_ ? (4095 - (qrowB - kb_) + 4 * hi) : (4096 + 4 * hi));
#pragma unroll
              for (int r = 0; r < 16; ++r) { const int cc = (r & 3) + 8 * (r >> 2); a0[r] = ta_[cc]; a1[r] = ta_[cc + 32]; b0[r] = tb_[cc]; b1[r] = tb_[cc + 32]; }
              const LAS unsigned char* kq_ = lds + D_KB + (t & 3) * 8192 + hi * 1024 + r32 * 16;
#pragma unroll
              for (int d0 = 0; d0 < 4; ++d0) { const bf16x8 kf0_ = *(const LAS bf16x8*)(kq_ + d0 * 2048), kf1_ = *(const LAS bf16x8*)(kq_ + d0 * 2048 + 512); const bf16x8 qa_ = QA(d0), qb_ = qrB[d0];
                  a0 = __builtin_amdgcn_mfma_f32_32x32x16_bf16(kf0_, qa_, a0, 0, 0, 0); a1 = __builtin_amdgcn_mfma_f32_32x32x16_bf16(kf1_, qa_, a1, 0, 0, 0);
                  b0 = __builtin_amdgcn_mfma_f32_32x32x16_bf16(kf0_, qb_, b0, 0, 0, 0); b1 = __builtin_amdgcn_mfma_f32_32x32x16_bf16(kf1_, qb_, b1, 0, 0, 0); } }
            MD_EXP(pwa, a0, a1, olA); MD_EXP(pwb, b0, b1, olB);
            { const int vb_ = vb0 + (t & 3) * 8192;
#pragma unroll
              for (int d0 = 0; d0 < 2; ++d0) { s16x4 vlo[4], vhi[4];
#pragma unroll
                  for (int ks = 0; ks < 4; ++ks) { vlo[ks] = __builtin_bit_cast(s16x4, __builtin_amdgcn_ds_read_tr16_b64_v4i16((LAS s16x4*)(uintptr_t)(unsigned)(vb_ + d0 * 4096 + ks * 1024)));
                                                   vhi[ks] = __builtin_bit_cast(s16x4, __builtin_amdgcn_ds_read_tr16_b64_v4i16((LAS s16x4*)(uintptr_t)(unsigned)(vb_ + d0 * 4096 + ks * 1024 + 512))); }
#pragma unroll
                  for (int ks = 0; ks < 4; ++ks) { const bf16x8 vf = (bf16x8){vlo[ks][0], vlo[ks][1], vlo[ks][2], vlo[ks][3], vhi[ks][0], vhi[ks][1], vhi[ks][2], vhi[ks][3]};
                      oA[d0] = __builtin_amdgcn_mfma_f32_32x32x16_bf16(__builtin_bit_cast(bf16x8, pwa[ks]), vf, oA[d0], 0, 0, 0);
                      oB[d0] = __builtin_amdgcn_mfma_f32_32x32x16_bf16(__builtin_bit_cast(bf16x8, pwb[ks]), vf, oB[d0], 0, 0, 0); } } }
        } else if (needB) {
            f32x16 b0, b1; u32x4 pwb[4];
            MD_QK(b0, b1, selB, qrowB, QB_, t); MD_EXP(pwb, b0, b1, olB); MD_PV(oB, pwb, t);
        }
        if (t + 3 < NT) asm volatile("s_waitcnt vmcnt(4) lgkmcnt(0)\n\ts_barrier" ::: "memory");
        else if (t + 2 < NT) asm volatile("s_waitcnt vmcnt(2) lgkmcnt(0)\n\ts_barrier" ::: "memory");
        else ATT_WAIT_BAR();
    }
    LAS bf16_t* stg = (LAS bf16_t*)(lds + D_OST) + wid * 2048;
    LAS float* wsf = (LAS float*)(lds + D_KM) + wid * 64;
#define MD_OUT(OO, OL, QB) do { { float l_ = OL + __shfl_xor(OL, 32); if (hi == 0) wsf[r32] = __builtin_amdgcn_rcpf(l_); } asm volatile("s_waitcnt lgkmcnt(0)" ::: "memory"); \
        _Pragma("unroll") for (int r = 0; r < 16; ++r) { const int orow = crow(r, hi); const float sc = wsf[orow]; \
            _Pragma("unroll") for (int d0 = 0; d0 < 2; ++d0) stg[orow * 64 + d0 * 32 + r32] = (bf16_t)(cvtpk(OO[d0][r] * sc, 0.f) & 0xffffu); } \
        asm volatile("s_waitcnt lgkmcnt(0)" ::: "memory"); \
        _Pragma("unroll") for (int i = 0; i < 4; ++i) { const int row = i * 8 + (lane >> 3), ch = lane & 7; const u32x4 v = *(const LAS u32x4*)(stg + row * 64 + ch * 8); \
            *(u32x4*)(O + (size_t)((QB) * 256 + qt * 32 + row) * 1024 + ch * 8) = v; } \
        asm volatile("s_waitcnt lgkmcnt(0)" ::: "memory"); } while (0)
    MD_OUT(oA, olA, qbA);
    MD_OUT(oB, olB, qbB);
    ATT_WAIT_BAR();
#undef MD_DMA
#undef MD_GATE
#undef MD_QK
#undef MD_EXP
#undef MD_PV
#undef MD_SB
#undef QA
#undef QB_
#undef MD_OUT
}
}

constexpr int NWAVES = 8;
#ifndef MK_N_LAUNCHES
#define MK_N_LAUNCHES 1
#endif
constexpr int N_LAUNCHES = MK_N_LAUNCHES, PER_PHASE = 12;
constexpr size_t MiB = 1u << 20;
constexpr size_t WS_CTL = 0, CTL_ZERO_BYTES = 32 * 1024;
constexpr size_t WS_SS = 1 * MiB;
constexpr size_t WS_KM = WS_SS + 512 * 1024;
constexpr size_t WS_TBLB = 2 * MiB;
constexpr size_t WS_TBLA = WS_TBLB + 512 * 1024;
constexpr size_t WS_LA = 3 * MiB;
constexpr size_t WS_W = 6 * MiB;
constexpr size_t W_QKV0 = WS_W, W_O0 = W_QKV0 + 9 * MiB, W_QKV1 = W_O0 + 1 * MiB, W_O1 = W_QKV1 + 6 * MiB, W_UP0 = W_O1 + 2 * MiB, W_UP1 = W_UP0 + 8 * MiB, W_DN0 = W_UP1 + 8 * MiB, W_DN1 = W_DN0 + 8 * MiB;
constexpr size_t WS_HB = 56 * MiB;
constexpr size_t WS_OG = 56 * MiB;
constexpr size_t WS_QKV = 104 * MiB;
constexpr size_t WS_O0 = 104 * MiB;
constexpr size_t WS_O1 = 200 * MiB;
constexpr size_t WS_H = 104 * MiB;
constexpr size_t WS_END = 256 * MiB;
static_assert(W_DN1 + 8 * MiB == WS_HB && WS_H + 128 * MiB <= WS_END && WS_QKV + 144 * MiB <= WS_END, "d_ws map");
constexpr int CW_BAR = 4096;
constexpr int RING_BYTES = 131072, LDS_BYTES = 163840, LDSCTL_OFF = LDS_BYTES - 512, MISC_OFF = LDSCTL_OFF + 320;
static_assert(att::S_END <= LDSCTL_OFF && att::D_END <= RING_BYTES, "attention LDS");

typedef GAS unsigned gu32;
#define RLX_AGENT __ATOMIC_RELAXED, __HIP_MEMORY_SCOPE_AGENT
#define XB_TMO      128
#define XB_XCNT(j)  (256  + 64 * (j))
#define XB_XSUB(j)  (1280 + 64 * (j))
#define XB_XGEN(j)  (2304 + 64 * (j))
#define XB_TOP      3328
#define XB_TOPGEN   3392
#define XCD_BAR_WORDS 3456
#define XB_SPIN_CAP (1u << 18)
__device__ __forceinline__ unsigned xb_ld(unsigned* p)              { return __hip_atomic_load(p, __ATOMIC_RELAXED, __HIP_MEMORY_SCOPE_AGENT); }
__device__ __forceinline__ unsigned xb_add(unsigned* p, unsigned v) { return __hip_atomic_fetch_add(p, v, __ATOMIC_RELAXED, __HIP_MEMORY_SCOPE_AGENT); }
__device__ __forceinline__ unsigned xb_xcc_id() { return (unsigned)__builtin_amdgcn_s_getreg((3 << 11) | 20) & 0xFu; }
#define XB_SPIN(cond, bar) do { unsigned _sp = 0; while (cond) { __builtin_amdgcn_s_sleep(1); \
    if ((++_sp & 255u) == 0u) { if (xb_ld(&(bar)[XB_TMO])) break; if (_sp > XB_SPIN_CAP) { atomicAdd(&(bar)[XB_TMO], 1u); break; } } } } while (0)
struct XcdBarrier { unsigned* bar; unsigned x; volatile LAS unsigned* st; };
__device__ __forceinline__ XcdBarrier xcd_barrier_post(unsigned* bar, volatile LAS unsigned* st) {
    XcdBarrier b; b.bar = bar; b.x = xb_xcc_id(); b.st = st;
    if (threadIdx.x == 0) (void)xb_add(&bar[XB_XCNT(b.x)], 1u);
    return b;
}
__device__ __forceinline__ void xcd_barrier_complete(unsigned* bar, unsigned x, unsigned& nloc, unsigned& nx) {
    const unsigned G = gridDim.x * gridDim.y * gridDim.z;
    unsigned sum, cnt, mine, sp = 0u;
    for (;;) {
        sum = 0u; cnt = 0u; mine = 0u;
#pragma unroll
        for (unsigned j = 0; j < 16; ++j) { const unsigned c = xb_ld(&bar[XB_XCNT(j)]); sum += c; cnt += (c > 0u) ? 1u : 0u; mine = (j == x) ? c : mine; }
        if (sum == G) break;
        __builtin_amdgcn_s_sleep(1);
        if ((++sp & 255u) == 0u) { if (xb_ld(&bar[XB_TMO])) break; if (sp > XB_SPIN_CAP) { atomicAdd(&bar[XB_TMO], 1u); break; } }
    }
    nloc = mine > 0u ? mine : 1u; nx = cnt > 0u ? cnt : 1u;
}
__device__ __forceinline__ void xcd_barrier(const XcdBarrier& b) {
    asm volatile("s_waitcnt vmcnt(0)" ::: "memory");
    __syncthreads();
    if (threadIdx.x == 0) {
        unsigned* bar = b.bar;
        __builtin_amdgcn_s_waitcnt(0);
        unsigned nloc = b.st[0], nx = b.st[1];
        if (nloc == 0u) { xcd_barrier_complete(bar, b.x, nloc, nx); b.st[0] = nloc; b.st[1] = nx; }
        const unsigned old = xb_add(&bar[XB_XSUB(b.x)], 1u);
        const unsigned gen = old / nloc;
        if (old + 1u == (gen + 1u) * nloc) {
            __builtin_amdgcn_fence(__ATOMIC_RELEASE, "agent");
            asm volatile("s_waitcnt vmcnt(0)" ::: "memory");
            const unsigned og = xb_add(&bar[XB_TOP], 1u);
            const unsigned tg = og / nx;
            if (og + 1u == (tg + 1u) * nx) xb_add(&bar[XB_TOPGEN], 1u);
            else XB_SPIN(xb_ld(&bar[XB_TOPGEN]) == tg, bar);
            __builtin_amdgcn_fence(__ATOMIC_ACQUIRE, "agent");
            xb_add(&bar[XB_XGEN(b.x)], 1u);
            asm volatile("s_waitcnt vmcnt(0)" ::: "memory");
        } else {
            XB_SPIN(xb_ld(&bar[XB_XGEN(b.x)]) == gen, bar);
            __builtin_amdgcn_fence(__ATOMIC_ACQUIRE, "agent");
            asm volatile("s_waitcnt vmcnt(0)" ::: "memory");
        }
    }
    __syncthreads();
}

__device__ __forceinline__ float wave_sum(float v) {
#pragma unroll
    for (int o = 1; o < 64; o <<= 1) v += __shfl_xor(v, o);
    return v;
}
__device__ __forceinline__ float wave_max(float v) {
#pragma unroll
    for (int o = 1; o < 64; o <<= 1) v = fmaxf(v, __shfl_xor(v, o));
    return v;
}
__device__ __forceinline__ void p0_transpose_item(const float* W, int K, int N, bf16_t* WT, const float* gain, bool perm, LAS float* scr, int item, int lane) {
    const int nblk = N / 32, kb = item / nblk, nb = item % nblk, k0 = 64 * kb, n0 = 32 * nb;
    const int kr = lane >> 3, c4 = (lane & 7) * 4;
    f32x4 v[8]; float gs[8];
#pragma unroll
    for (int i = 0; i < 8; ++i) { v[i] = *(const f32x4*)(W + (size_t)(k0 + 8 * i + kr) * N + n0 + c4); gs[i] = gain ? gain[k0 + 8 * i + kr] : 1.f; }
#pragma unroll
    for (int i = 0; i < 8; ++i) { LAS float* s = scr + (8 * i + kr) * 33 + c4; s[0] = v[i][0] * gs[i]; s[1] = v[i][1] * gs[i]; s[2] = v[i][2] * gs[i]; s[3] = v[i][3] * gs[i]; }
    asm volatile("s_waitcnt lgkmcnt(0)" ::: "memory");
    const int c = lane & 7;
    const int orow0 = perm ? ((n0 & ~255) + ((n0 >> 5) & 1) * 128 + ((n0 >> 6) & 3) * 32) : n0;
#pragma unroll
    for (int j = 0; j < 4; ++j) { const int n = (lane >> 3) + 8 * j; const LAS float* s = scr + (8 * c) * 33 + n;
        u32x4 o; o.x = cvtpk(s[0 * 33], s[1 * 33]); o.y = cvtpk(s[2 * 33], s[3 * 33]); o.z = cvtpk(s[4 * 33], s[5 * 33]); o.w = cvtpk(s[6 * 33], s[7 * 33]);
        *(u32x4*)(WT + (size_t)(orow0 + n) * K + k0 + 8 * c) = o; }
    asm volatile("s_waitcnt lgkmcnt(0)" ::: "memory");
}
__device__ __forceinline__ int t5_bucket(int n) {
    if (n < 16) return n;
    const int thr[15] = {22, 30, 40, 54, 73, 99, 134, 182, 246, 332, 450, 609, 825, 1117, 1513};
    int b = 16;
#pragma unroll
    for (int k = 0; k < 15; ++k) b += (n >= thr[k]) ? 1 : 0;
    return b;
}

struct Args { const float* in[14]; float* out; unsigned char* ws; int ph_lo, ph_hi, li, pad; };

__global__ void __launch_bounds__(NWAVES * 64, 2) hybrid_fwd(Args args) {
    extern __shared__ __attribute__((aligned(16))) unsigned char lds_raw[];
    LAS unsigned char* lds = (LAS unsigned char*)lds_raw;
    volatile LAS unsigned* MISC = (volatile LAS unsigned*)(lds + MISC_OFF);
    const int tid = threadIdx.x, lane = tid & 63, wave = __builtin_amdgcn_readfirstlane(tid >> 6);
    const int G = gridDim.x, bx = blockIdx.x, vcu = (G % 8 == 0) ? (bx % 8) * (G / 8) + bx / 8 : bx;
    unsigned char* ws = args.ws;
    unsigned* ctl = (unsigned*)(ws + WS_CTL);
    const float* x = args.in[0]; const float* rel_bias = args.in[1]; const float* norm_mix = args.in[2]; const float* norm_ffn = args.in[3];
    const float* a_w_qkv = args.in[4]; const float* a_q_gain = args.in[5]; const float* a_k_gain = args.in[6]; const float* a_w_o = args.in[7];
    const float* b_w_qkv = args.in[8]; const float* b_q_gain = args.in[9]; const float* b_k_gain = args.in[10]; const float* b_w_o = args.in[11];
    const float* ffn_w1 = args.in[12]; const float* ffn_w2 = args.in[13];
    float* out = args.out;
    float* ssp = (float*)(ws + WS_SS); float* kmp = (float*)(ws + WS_KM); float* tblB = (float*)(ws + WS_TBLB); float* tblA = (float*)(ws + WS_TBLA); float* la = (float*)(ws + WS_LA);
    bf16_t* HB = (bf16_t*)(ws + WS_HB); bf16_t* OG = (bf16_t*)(ws + WS_OG); bf16_t* QKV = (bf16_t*)(ws + WS_QKV); bf16_t* O0 = (bf16_t*)(ws + WS_O0); bf16_t* O1 = (bf16_t*)(ws + WS_O1); bf16_t* HH = (bf16_t*)(ws + WS_H);

    for (int u = tid; u < (LDS_BYTES - LDSCTL_OFF) / 4; u += NWAVES * 64) ((LAS unsigned*)(lds + LDSCTL_OFF))[u] = 0u;
    __syncthreads();
    XcdBarrier bar; bar.bar = ctl + CW_BAR; bar.x = 0; bar.st = nullptr;
    if (N_LAUNCHES != PER_PHASE) bar = xcd_barrier_post(ctl + CW_BAR, MISC + 8);
#define GRID_BAR() do { if (N_LAUNCHES != PER_PHASE) xcd_barrier(bar); } while (0)
    const int lo = args.ph_lo, hi = args.ph_hi;
#define IN(k) (lo <= (k) && (k) < hi)
#define BOTH(k) (IN(k) && IN((k) + 1))

    constexpr int I0 = (DM / 64) * (NQKV0 / 32), I1 = (NO0 / 64) * (DM / 32), I2 = (DM / 64) * (NQKV1 / 32), I3 = (NO1 / 64) * (DM / 32), I4 = (DM / 64) * (FF / 32), I5 = (FF / 64) * (DM / 32);
    constexpr int NITEMS_A = I0 + I1, NITEMS = NITEMS_A + I4 + I5 + I2 + I3 + I4 + I5;
#define P0_ITEM(it_) do { int r = (it_); LAS float* scr_ = (LAS float*)(lds + wave * 16384); \
        if (r < I0) { p0_transpose_item(a_w_qkv, DM, NQKV0, (bf16_t*)(ws + W_QKV0), norm_mix, true, scr_, r, lane); break; } r -= I0; \
        if (r < I1) { p0_transpose_item(a_w_o, NO0, DM, (bf16_t*)(ws + W_O0), nullptr, false, scr_, r, lane); break; } r -= I1; \
        if (r < I4) { p0_transpose_item(ffn_w1, DM, FF, (bf16_t*)(ws + W_UP0), norm_ffn, false, scr_, r, lane); break; } r -= I4; \
        if (r < I5) { p0_transpose_item(ffn_w2, FF, DM, (bf16_t*)(ws + W_DN0), nullptr, false, scr_, r, lane); break; } r -= I5; \
        if (r < I2) { p0_transpose_item(b_w_qkv, DM, NQKV1, (bf16_t*)(ws + W_QKV1), norm_mix + DM, true, scr_, r, lane); break; } r -= I2; \
        if (r < I3) { p0_transpose_item(b_w_o, NO1, DM, (bf16_t*)(ws + W_O1), nullptr, false, scr_, r, lane); break; } r -= I3; \
        if (r < I4) { p0_transpose_item(ffn_w1 + (size_t)DM * FF, DM, FF, (bf16_t*)(ws + W_UP1), norm_ffn + DM, false, scr_, r, lane); break; } r -= I4; \
        p0_transpose_item(ffn_w2 + (size_t)FF * DM, FF, DM, (bf16_t*)(ws + W_DN1), nullptr, false, scr_, r, lane); } while (0)
    if (IN(0)) {
        const int gw = vcu * NWAVES + wave, NGW = G * NWAVES;
        for (int it = gw; it < NITEMS_A; it += NGW) P0_ITEM(it);
        for (int m = 2 * gw; m < MTOK; m += 2 * NGW) {
            f32x4 v[2][4]; float s[2] = {0.f, 0.f};
#pragma unroll
            for (int q = 0; q < 2; ++q)
#pragma unroll
                for (int j = 0; j < 2; ++j) { const f32x4* xp = (const f32x4*)(x + (size_t)(m + q) * DM + 512 * j + 8 * lane); v[q][2 * j] = xp[0]; v[q][2 * j + 1] = xp[1]; }
#pragma unroll
            for (int q = 0; q < 2; ++q) {
#pragma unroll
                for (int j = 0; j < 4; ++j) s[q] += (v[q][j][0] * v[q][j][0] + v[q][j][1] * v[q][j][1]) + (v[q][j][2] * v[q][j][2] + v[q][j][3] * v[q][j][3]);
                s[q] = wave_sum(s[q]);
#pragma unroll
                for (int j = 0; j < 2; ++j) { u32x4 w; w.x = cvtpk(v[q][2 * j][0], v[q][2 * j][1]); w.y = cvtpk(v[q][2 * j][2], v[q][2 * j][3]); w.z = cvtpk(v[q][2 * j + 1][0], v[q][2 * j + 1][1]); w.w = cvtpk(v[q][2 * j + 1][2], v[q][2 * j + 1][3]);
                    *(u32x4*)(HB + (size_t)(m + q) * DM + 512 * j + 8 * lane) = w; }
                if (lane == 0) *(f32x4*)(ssp + (size_t)(m + q) * 4) = (f32x4){s[q], 0.f, 0.f, 0.f};
            }
        }
        {
            float mb = 0.f;
            for (int i = lane; i < 32 * 24; i += 64) mb = fmaxf(mb, rel_bias[i]);
            mb = wave_max(mb);
            const float refA = (8.f * wave_max(fabsf(a_q_gain[lane])) * wave_max(fabsf(a_k_gain[lane])) + mb) * LOG2E;
            const float refB = (8.f * wave_max(fabsf(b_q_gain[lane])) * wave_max(fabsf(b_k_gain[lane])) + mb) * LOG2E;
            const int gt = vcu * 512 + tid, NGT = G * 512;
            for (int e = gt; e < 16 * TBLB_N; e += NGT) { const int h = e / TBLB_N, idx = e % TBLB_N, dist = 4095 - idx;
                tblB[e] = (dist < 0) ? NEGV : rel_bias[t5_bucket(dist) * 24 + h] * LOG2E - refB; }
            for (int e = gt; e < 24 * TBLA_N; e += NGT) { const int col = e / TBLA_N, idx = e % TBLA_N, dist = 383 - idx, g = col >> 3;
                tblA[e] = (dist < 0 || dist > 128) ? NEGV : rel_bias[t5_bucket(dist << (2 * g)) * 24 + col] * LOG2E - refA; }
        }
        if (BOTH(0)) GRID_BAR();
    }
    if (IN(1)) {
        pg8::Gemm g{HB, (const bf16_t*)(ws + W_QKV0), MTOK, NQKV0, DM}; pg8::StaticOrder S; S.init(MTOK, NQKV0, G, bx);
        pg8::EpiQKV E{0, ssp, a_q_gain, a_k_gain, QKV, nullptr};
        pg8::gemm_phase<pg8::EpiQKV, pg8::StaticOrder, true, true>(lds, g, S, E);
        {
            const int nun = (MTOK / 256) * (NQKV0 / 256), full = nun % G, nidle = full ? G - full : G;
            if (bx >= full || full == 0) { const int iw = ((full ? bx - full : bx) * NWAVES + wave), NIW = nidle * NWAVES;
                for (int it = NITEMS_A + iw; it < NITEMS; it += NIW) P0_ITEM(it); }
        }
        if (BOTH(1)) GRID_BAR();
    }
    if (IN(2)) {
        const int nit = 768, perw = (nit + G - 1) / G;
        for (int k = 0; k < 3; ++k) {
            int item;
            if (G == 256) item = (k == 0) ? vcu : 256 + 2 * vcu + (k - 1);
            else { item = vcu * perw + k; if (k >= perw || item >= nit) break; }
            int g, sq, i0, R;
            if (item < 128) { g = 0; sq = item >> 2; i0 = (item & 3) * 32; R = 4; }
            else if (item < 256) { g = 1; sq = item - 128; i0 = 0; R = 4; }
            else { g = 2; sq = item - 256; i0 = 0; R = 1; }
            const int sh = 2 * g, dil = 1 << sh, Lg = SEQ >> sh, hh = sq & 7, vb = sq >> 3, b = vb >> sh, c = vb & (dil - 1);
            att::StreamDesc U;
            const size_t seqoff = (size_t)sq * Lg * 64;
            U.Q = QKV + (size_t)(0 * 3 + g) * ((size_t)MTOK * 512) + seqoff; U.K = QKV + (size_t)(1 * 3 + g) * ((size_t)MTOK * 512) + seqoff; U.V = QKV + (size_t)(2 * 3 + g) * ((size_t)MTOK * 512) + seqoff;
            U.i0 = i0; U.R = R; U.tblg = tblA + (size_t)(g * 8 + hh) * TBLA_N;
            U.O = OG + (size_t)g * ((size_t)MTOK * 512) + hh * 64; U.o_row0 = b * SEQ + c; U.o_rstride = dil;
            U.L = la + (size_t)g * ((size_t)MTOK * 8) + hh;
            att::stream(lds, U);
        }
        if (BOTH(2)) GRID_BAR();
    }
    if (IN(3)) {
        const int gt = vcu * 512 + tid, NGT = G * 512;
        for (int e = gt; e < MTOK * 64; e += NGT) {
            const int row = e >> 6, c8 = e & 63, hh = c8 >> 3;
            float acc8[8] = {0.f, 0.f, 0.f, 0.f, 0.f, 0.f, 0.f, 0.f}; float l = 0.f;
#pragma unroll
            for (int g = 0; g < 3; ++g) { const u32x4 w = *(const u32x4*)(OG + (size_t)g * ((size_t)MTOK * 512) + (size_t)row * 512 + c8 * 8);
                l += la[(size_t)g * ((size_t)MTOK * 8) + (size_t)row * 8 + hh];
#pragma unroll
                for (int k = 0; k < 4; ++k) { acc8[2 * k] += __builtin_bit_cast(float, w[k] << 16); acc8[2 * k + 1] += __builtin_bit_cast(float, w[k] & 0xffff0000u); } }
            const float rl = 1.f / l; u32x4 o;
            o.x = cvtpk(acc8[0] * rl, acc8[1] * rl); o.y = cvtpk(acc8[2] * rl, acc8[3] * rl); o.z = cvtpk(acc8[4] * rl, acc8[5] * rl); o.w = cvtpk(acc8[6] * rl, acc8[7] * rl);
            *(u32x4*)(O0 + (size_t)row * 512 + c8 * 8) = o;
        }
        if (BOTH(3)) GRID_BAR();
    }
    if (IN(4)) {
        pg8::Gemm g{O0, (const bf16_t*)(ws + W_O0), MTOK, DM, NO0}; pg8::StaticOrder S; S.init(MTOK, DM, G, bx);
        pg8::EpiRes<0> E{x, out, HB, ssp};
        pg8::gemm_phase<pg8::EpiRes<0>, pg8::StaticOrder, false, true>(lds, g, S, E);
        if (BOTH(4)) GRID_BAR();
    }
#define UP_PHASE(PU, WUP) \
    if (IN(PU)) { pg8::Gemm g{HB, (const bf16_t*)(ws + (WUP)), MTOK, FF, DM}; pg8::StaticOrder S; S.init(MTOK, FF, G, bx); pg8::EpiUp E{ssp, HH}; \
        pg8::gemm_phase<pg8::EpiUp, pg8::StaticOrder, true, true>(lds, g, S, E); if (BOTH(PU)) GRID_BAR(); }
#define DN_PHASE(PD, WDN, MODE) \
    if (IN(PD)) { pg8::Gemm g{HH, (const bf16_t*)(ws + (WDN)), MTOK, DM, FF}; pg8::StaticOrder S; S.init(MTOK, DM, G, bx); pg8::EpiRes<MODE> E{nullptr, out, HB, ssp}; \
        pg8::gemm_phase<pg8::EpiRes<MODE>, pg8::StaticOrder, false, true>(lds, g, S, E); if (BOTH(PD)) GRID_BAR(); }
    UP_PHASE(5, W_UP0)
    DN_PHASE(6, W_DN0, 1)
    if (IN(7)) {
        pg8::Gemm g{HB, (const bf16_t*)(ws + W_QKV1), MTOK, NQKV1, DM}; pg8::StaticOrder S; S.init(MTOK, NQKV1, G, bx);
        pg8::EpiQKV E{1, ssp, b_q_gain, b_k_gain, QKV, kmp};
        pg8::gemm_phase<pg8::EpiQKV, pg8::StaticOrder, true, true>(lds, g, S, E);
        if (BOTH(7)) GRID_BAR();
    }
    if (IN(8)) {
        const int per = (512 + G - 1) / G;
        for (int i = 0; i < per; ++i) {
            int bh, p;
            if (per == 2) { const int s = vcu & 3; bh = vcu >> 2; p = (i == 0) ? s : 7 - s; }
            else { const int uid = vcu * per + i; if (uid >= 512) break; bh = uid >> 3; p = uid & 7; }
            const int b = bh >> 4, h = bh & 15;
            const size_t seqoff = (size_t)bh * SEQ * 64;
            att::moba_pair(lds, p, QKV + seqoff, QKV + (size_t)MTOK * 1024 + seqoff, QKV + (size_t)2 * MTOK * 1024 + seqoff, tblB + (size_t)h * TBLB_N,
                           kmp + (((size_t)0 * BATCH + b) * 16 * 16 + h) * 64, kmp + (((size_t)1 * BATCH + b) * 16 * 16 + h) * 64, O1 + (size_t)(b * SEQ) * 1024 + h * 64);
        }
        if (BOTH(8)) GRID_BAR();
    }
    if (IN(9)) {
        pg8::Gemm g{O1, (const bf16_t*)(ws + W_O1), MTOK, DM, NO1}; pg8::StaticOrder S; S.init(MTOK, DM, G, bx);
        pg8::EpiRes<1> E{nullptr, out, HB, ssp};
        pg8::gemm_phase<pg8::EpiRes<1>, pg8::StaticOrder, false, true>(lds, g, S, E);
        if (BOTH(9)) GRID_BAR();
    }
    UP_PHASE(10, W_UP1)
    DN_PHASE(11, W_DN1, 2)
#undef IN
#undef BOTH
}

extern "C" void kernel_launch(void* const* d_in, const int* in_sizes, int n_in, void* d_out, int out_size, void* d_ws, size_t ws_size, hipStream_t stream) {
    static int grid = 0;
    if (grid == 0) {
        if (n_in != 14 || in_sizes[0] != MTOK * DM || out_size != MTOK * DM || ws_size < WS_END) { fprintf(stderr, "kernel_launch: unexpected shapes (n_in %d, in0 %d, out %d, ws %zu); nothing launched\n", n_in, n_in > 0 ? in_sizes[0] : -1, out_size, ws_size); grid = -1; return; }
        int dev = 0, cus = 0, per_cu = 0;
        if (hipGetDevice(&dev) != hipSuccess || hipDeviceGetAttribute(&cus, hipDeviceAttributeMultiprocessorCount, dev) != hipSuccess) { fprintf(stderr, "kernel_launch: device query failed\n"); grid = -1; return; }
        if (hipFuncSetAttribute((const void*)hybrid_fwd, hipFuncAttributeMaxDynamicSharedMemorySize, LDS_BYTES) != hipSuccess) { fprintf(stderr, "kernel_launch: hipFuncSetAttribute failed\n"); grid = -1; return; }
        if (hipOccupancyMaxActiveBlocksPerMultiprocessor(&per_cu, (const void*)hybrid_fwd, NWAVES * 64, LDS_BYTES) != hipSuccess || per_cu < 1) fprintf(stderr, "kernel_launch: note: occupancy query reports %d workgroups per CU\n", per_cu);
        (void)hipGetLastError();
        grid = cus;
        if (grid != 256) { fprintf(stderr, "kernel_launch: built for a 256-CU device, found %d CUs; nothing launched\n", cus); grid = -1; return; }
    }
    if (grid < 0) return;
    if (hipMemsetAsync((char*)d_ws + WS_CTL, 0, CTL_ZERO_BYTES, stream) != hipSuccess) { fprintf(stderr, "kernel_launch: hipMemsetAsync failed\n"); return; }
    Args a{};
    for (int i = 0; i < 14; ++i) a.in[i] = (const float*)d_in[i];
    a.out = (float*)d_out; a.ws = (unsigned char*)d_ws;
    if (N_LAUNCHES == 1) { a.ph_lo = 0; a.ph_hi = PER_PHASE; a.li = 0; hipLaunchKernelGGL(hybrid_fwd, dim3(grid), dim3(NWAVES * 64), LDS_BYTES, stream, a); }
    else for (int li = 0; li < PER_PHASE; ++li) { a.ph_lo = li; a.ph_hi = li + 1; a.li = li; hipLaunchKernelGGL(hybrid_fwd, dim3(grid), dim3(NWAVES * 64), LDS_BYTES, stream, a); }
    const hipError_t le = hipPeekAtLastError();
    if (le != hipSuccess) fprintf(stderr, "kernel_launch: launch failed: %s\n", hipGetErrorName(le));
}
```

```cpp
#include <hip/hip_runtime.h>
#include <cstdio>
#include <cstdint>

#define LAS __attribute__((address_space(3)))
#define GAS __attribute__((address_space(1)))
typedef unsigned short bf16_t;
typedef short bf16x8 __attribute__((ext_vector_type(8)));
typedef short s16x4 __attribute__((ext_vector_type(4)));
typedef float f32x4 __attribute__((ext_vector_type(4)));
typedef float f32x2 __attribute__((ext_vector_type(2)));
typedef float f32x16 __attribute__((ext_vector_type(16)));
typedef unsigned u32x4 __attribute__((ext_vector_type(4)));
typedef unsigned u32x2 __attribute__((ext_vector_type(2)));
typedef int i32x8 __attribute__((ext_vector_type(8)));
typedef int i32x4_ __attribute__((ext_vector_type(4)));
typedef __bf16 bf16x2_t __attribute__((ext_vector_type(2)));

constexpr int BATCH = 4, SEQ = 4096, DM = 1024, MTOK = BATCH * SEQ, FF = 4096, HD = 64;
constexpr int NQKV0 = 4608, NO0 = 512, NQKV1 = 3072, NO1 = 1024;
constexpr float EPS = 1e-6f, LOG2E = 1.4426950408889634f, QSCALE = 0.125f * LOG2E, NEGV = -1e30f;
constexpr int TBLB_N = 4352, TBLA_N = 640, TOFF = 255;

__device__ __forceinline__ unsigned cvtpk(float lo, float hi) { f32x2 v = {lo, hi}; bf16x2_t b = __builtin_convertvector(v, bf16x2_t); return __builtin_bit_cast(unsigned, b); }
__device__ __forceinline__ float bf2f(unsigned short h) { return __builtin_bit_cast(float, (unsigned)h << 16); }
__device__ __forceinline__ float rsq(float x) { return __builtin_amdgcn_rsqf(x); }

__device__ __forceinline__ unsigned pk4_bf8(float a, float b, float c, float d) { int w = __builtin_amdgcn_cvt_pk_bf8_f32(a, b, 0, false); return (unsigned)__builtin_amdgcn_cvt_pk_bf8_f32(c, d, w, true); }
__device__ __forceinline__ unsigned pk4_fp8(float a, float b, float c, float d) { int w = __builtin_amdgcn_cvt_pk_fp8_f32(a, b, 0, false); return (unsigned)__builtin_amdgcn_cvt_pk_fp8_f32(c, d, w, true); }
namespace pg8 {
constexpr int BM = 256, BK = 64, HALF = 128, HTB = HALF * BK * 2, STAGE_BYTES = 8 * HTB, NXCD = 8, WGM = 4;
__host__ __device__ __forceinline__ int lds_byte(int r, int c) { const int st = (r >> 4) * 2 + (c >> 5), rr = r & 15, cc = c & 31, ob = rr * 64 + cc * 2; return st * 1024 + (ob ^ (((ob >> 9) & 1) << 5)); }
__host__ __device__ __forceinline__ void stage_rc(int b, int& R, int& C) { const int st = b / 1024, sb = b % 1024, swz = sb ^ (((sb >> 9) & 1) << 5); R = (st >> 1) * 16 + swz / 64; C = (st & 1) * 32 + (swz % 64) / 2; }
__host__ __device__ __forceinline__ int perm32(int rho) { const int n = rho >> 4, i = rho & 15; return 8 * (i >> 2) + 4 * n + (i & 3); }
struct Unit { int pm, pn; };
struct Gemm { const bf16_t* A; const bf16_t* Bt; int M, N, K; };
struct StaticOrder {
    int nM, nN, nwg, G, c;
    __host__ __device__ void init(int M, int N, int G_, int c_) { nM = M / BM; nN = N / BM; nwg = nM * nN; G = G_; c = c_; }
    __host__ __device__ bool next(int i, Unit& u) const {
        const long L = (long)i * G + c; if (L >= nwg) return false;
        int wgid = (int)L; { const int q = nwg / NXCD, r = nwg % NXCD, xcd = wgid % NXCD, off = wgid / NXCD; wgid = (xcd < r ? xcd * (q + 1) : r * (q + 1) + (xcd - r) * q) + off; }
        const int nig = WGM * nN, gid = wgid / nig, fm = gid * WGM, gsz = (nM - fm) < WGM ? (nM - fm) : WGM;
        u.pm = fm + ((wgid % nig) % gsz); u.pn = (wgid % nig) / gsz; return true;
    }
};

struct EpiQKV {
    static constexpr bool PERM = true, AFTER_DRAIN = false;
    int layer; const float* ssp; const float* gq; const float* gk; bf16_t* dst; float* kmp; int pn_off;
    __device__ __forceinline__ void operator()(const f32x4 (&acc)[2][2][4][2], const Unit& u, int wr, int wc, int fr, int fq) const {
        const int pn = u.pn + pn_off, pm = u.pm; int kind, hh, g = 0;
        if (layer == 0) { kind = pn / 6; const int rem = pn % 6; g = rem >> 1; hh = (rem & 1) * 4 + wc; } else { kind = pn >> 2; hh = (pn & 3) * 4 + wc; }
        f32x4 gv[2][2]; const float* gp = (kind == 0) ? gq : gk;
#pragma unroll
        for (int bj = 0; bj < 2; ++bj)
#pragma unroll
            for (int n = 0; n < 2; ++n) gv[bj][n] = *(const f32x4*)(gp + 32 * bj + 8 * fq + 4 * n);
        f32x4 cs[2][2];
#pragma unroll
        for (int bj = 0; bj < 2; ++bj)
#pragma unroll
            for (int n = 0; n < 2; ++n) cs[bj][n] = (f32x4){0.f, 0.f, 0.f, 0.f};
        const bool km = (layer == 1 && kind == 1);
#pragma unroll
        for (int ai = 0; ai < 2; ++ai)
#pragma unroll
            for (int m = 0; m < 4; ++m) {
                const int row = pm * BM + ai * HALF + wr * 64 + m * 16 + fr;
                const f32x4 pv = *(const f32x4*)(ssp + (size_t)row * 4);
                const float r = rsq(((pv[0] + pv[1]) + (pv[2] + pv[3])) * (1.f / 1024.f) + EPS);
                f32x4 v[2][2];
#pragma unroll
                for (int bj = 0; bj < 2; ++bj)
#pragma unroll
                    for (int n = 0; n < 2; ++n) v[bj][n] = acc[ai][bj][m][n] * r;
                if (kind < 2) {
                    float s = 0.f;
#pragma unroll
                    for (int bj = 0; bj < 2; ++bj)
#pragma unroll
                        for (int n = 0; n < 2; ++n) { const f32x4 x = v[bj][n]; s += (x[0] * x[0] + x[1] * x[1]) + (x[2] * x[2] + x[3] * x[3]); }
                    s += __shfl_xor(s, 16); s += __shfl_xor(s, 32);
                    float rn = rsq(s * (1.f / 64.f) + EPS); if (kind == 0) rn *= QSCALE;
#pragma unroll
                    for (int bj = 0; bj < 2; ++bj)
#pragma unroll
                        for (int n = 0; n < 2; ++n) { v[bj][n] = v[bj][n] * rn * gv[bj][n]; if (km) cs[bj][n] += v[bj][n]; }
                }
                const int b = row >> 12, t = row & 4095; size_t off;
                if (layer == 0) { const int sh = 2 * g, c = t & ((1 << sh) - 1), l = t >> sh;
                    off = (size_t)(kind * 3 + g) * ((size_t)MTOK * 512) + ((((size_t)((b << sh) + c)) * 8 + hh) * (size_t)(4096 >> sh) + l) * 64; }
                else off = (size_t)kind * ((size_t)MTOK * 1024) + (((size_t)b * 16 + hh) * 4096 + t) * 64;
                if (kind == 1) {
                    unsigned char* p8;
                    if (layer == 0) { const int sh = 2 * g, c = t & ((1 << sh) - 1), l = t >> sh;
                        p8 = (unsigned char*)(dst + (size_t)(3 + g) * ((size_t)MTOK * 512)) + ((((size_t)((b << sh) + c)) * 8 + hh) * (size_t)(4096 >> sh) + l) * 64 + 8 * fq; }
                    else p8 = (unsigned char*)(dst + (size_t)MTOK * 1024) + (((size_t)b * 16 + hh) * 4096 + t) * 64 + 8 * fq;
#pragma unroll
                    for (int bj = 0; bj < 2; ++bj) { u32x2 w8; w8.x = pk4_fp8(v[bj][0][0], v[bj][0][1], v[bj][0][2], v[bj][0][3]); w8.y = pk4_fp8(v[bj][1][0], v[bj][1][1], v[bj][1][2], v[bj][1][3]);
                        *(u32x2*)(p8 + 32 * bj) = w8; }
                } else {
                bf16_t* p = dst + off + 8 * fq;
#pragma unroll
                for (int bj = 0; bj < 2; ++bj) { u32x4 w; w.x = cvtpk(v[bj][0][0], v[bj][0][1]); w.y = cvtpk(v[bj][0][2], v[bj][0][3]); w.z = cvtpk(v[bj][1][0], v[bj][1][1]); w.w = cvtpk(v[bj][1][2], v[bj][1][3]);
                    *(u32x4*)(p + 32 * bj) = w; }
                }
            }
        if (km) {
#pragma unroll
            for (int bj = 0; bj < 2; ++bj)
#pragma unroll
                for (int n = 0; n < 2; ++n)
#pragma unroll
                    for (int e = 0; e < 4; ++e) { float x = cs[bj][n][e]; x += __shfl_xor(x, 1); x += __shfl_xor(x, 2); x += __shfl_xor(x, 4); x += __shfl_xor(x, 8); cs[bj][n][e] = x; }
            if (fr == 0) { const int b = pm >> 4, nb = pm & 15; float* kp = kmp + ((((size_t)wr * BATCH + b) * 16 + nb) * 16 + hh) * 64 + 8 * fq;
#pragma unroll
                for (int bj = 0; bj < 2; ++bj)
#pragma unroll
                    for (int n = 0; n < 2; ++n) *(f32x4*)(kp + 32 * bj + 4 * n) = cs[bj][n]; }
        }
    }
};
struct EpiVT {
    static constexpr bool PERM = true, AFTER_DRAIN = false;
    const float* ssp; unsigned char* v8t;
    __device__ __forceinline__ void operator()(const f32x4 (&acc)[2][2][4][2], const Unit& u, int wr, int wc, int fr, int fq) const {
        float rt[2][8];
#pragma unroll
        for (int bj = 0; bj < 2; ++bj)
#pragma unroll
            for (int i = 0; i < 8; ++i) { const f32x4 pv = *(const f32x4*)(ssp + (size_t)(u.pn * BM + bj * HALF + wc * 32 + 8 * fq + i) * 4); rt[bj][i] = rsq(((pv[0] + pv[1]) + (pv[2] + pv[3])) * (1.f / 1024.f) + EPS); }
#pragma unroll
        for (int ai = 0; ai < 2; ++ai)
#pragma unroll
            for (int m = 0; m < 4; ++m) {
                const int rowg = u.pm * BM + ai * HALF + wr * 64 + m * 16 + fr, hh = rowg >> 6, d = rowg & 63;
#pragma unroll
                for (int bj = 0; bj < 2; ++bj) { const int tok = u.pn * BM + bj * HALF + wc * 32 + 8 * fq, b = tok >> 12, t = tok & 4095;
                    const f32x4 x0 = acc[ai][bj][m][0], x1 = acc[ai][bj][m][1]; u32x2 w8;
                    w8.x = pk4_fp8(x0[0] * rt[bj][0], x0[1] * rt[bj][1], x0[2] * rt[bj][2], x0[3] * rt[bj][3]); w8.y = pk4_fp8(x1[0] * rt[bj][4], x1[1] * rt[bj][5], x1[2] * rt[bj][6], x1[3] * rt[bj][7]);
                    *(u32x2*)(v8t + ((((size_t)b * 16 + hh) * 64 + (t >> 6)) * 64 + d) * 64 + (t & 63)) = w8; }
            }
    }
};
struct EpiQKVT {
    static constexpr bool PERM = true, AFTER_DRAIN = false;
    EpiQKV q; EpiVT v; int pm0, pn0;
    __device__ __forceinline__ void operator()(const f32x4 (&acc)[2][2][4][2], const Unit& u, int wr, int wc, int fr, int fq) const {
        if (u.pn >= pn0) { const Unit w{u.pm - pm0, u.pn - pn0}; v(acc, w, wr, wc, fr, fq); } else q(acc, u, wr, wc, fr, fq);
    }
};
struct QKVTOrder {
    StaticOrder s0, s1; int first1, pm0, pn0;
    __host__ __device__ void init(int M, int G, int c, int pm0_, int pn0_) { s0.init(M, 2048, G, c); s1.init(1024, M, G, c); first1 = s0.nwg / G; pm0 = pm0_; pn0 = pn0_; }
    __host__ __device__ bool next(int i, Unit& u) const {
        if (i < first1) return s0.next(i, u);
        if (!s1.next(i - first1, u)) return false;
        u.pm += pm0; u.pn += pn0; return true;
    }
};
struct SkipFirstPanelOrder {
    StaticOrder s;
    __host__ __device__ void init(int G, int c) { s.init(60 * 256, 4608, G, c); }
    __host__ __device__ bool next(int i, Unit& u) const { if (!s.next(i, u)) return false; u.pm += u.pm / 15 + 1; return true; }
};
struct FirstPanelOrder {
    int G, c;
    __host__ __device__ void init(int G_, int c_) { G = G_; c = c_; }
    __host__ __device__ bool next(int i, Unit& u) const {
        const int e = i * G + (G - 1 - c); if (e >= 72) return false;
        u.pm = 16 * (e / 18); u.pn = e % 18; return true;
    }
};
struct EpiUp {
    static constexpr bool PERM = true, AFTER_DRAIN = false;
    const float* ssp; bf16_t* H;
    __device__ __forceinline__ void operator()(const f32x4 (&acc)[2][2][4][2], const Unit& u, int wr, int wc, int fr, int fq) const {
#pragma unroll
        for (int ai = 0; ai < 2; ++ai)
#pragma unroll
            for (int m = 0; m < 4; ++m) {
                const int row = u.pm * BM + ai * HALF + wr * 64 + m * 16 + fr;
                const f32x4 pv = *(const f32x4*)(ssp + (size_t)row * 4);
                const float r = rsq(((pv[0] + pv[1]) + (pv[2] + pv[3])) * (1.f / 1024.f) + EPS);
                bf16_t* rowp = H + (size_t)row * FF + u.pn * BM + wc * 32 + 8 * fq;
#pragma unroll
                for (int bj = 0; bj < 2; ++bj) { f32x4 v0 = acc[ai][bj][m][0] * r, v1 = acc[ai][bj][m][1] * r;
#pragma unroll
                    for (int e = 0; e < 4; ++e) { const float a = fmaxf(v0[e], 0.f), b = fmaxf(v1[e], 0.f); v0[e] = a * a; v1[e] = b * b; }
                    u32x4 w; w.x = cvtpk(v0[0], v0[1]); w.y = cvtpk(v0[2], v0[3]); w.z = cvtpk(v1[0], v1[1]); w.w = cvtpk(v1[2], v1[3]);
                    *(u32x4*)(rowp + bj * HALF) = w; }
            }
    }
};
template <int MODE> struct EpiRes {
    static constexpr bool PERM = true, AFTER_DRAIN = true;
    const float* basef; float* out; bf16_t* hb; float* ssp;
    __device__ __forceinline__ void fused(f32x4 (&acc)[2][2][4][2], const Unit& u, int wr, int wc, int fr, int fq, LAS unsigned char* lds, int wid, int lane) const {
        LAS float* P = (LAS float*)lds;
        const int col0 = u.pn * BM + wc * 32 + 8 * fq;
#pragma unroll
        for (int ai = 0; ai < 2; ++ai)
#pragma unroll
            for (int m = 0; m < 4; ++m) {
                const int rl = ai * HALF + wr * 64 + m * 16 + fr; const size_t off = (size_t)(u.pm * BM + rl) * DM + col0; float s = 0.f;
                f32x4 bv[2][2];
#pragma unroll
                for (int bj = 0; bj < 2; ++bj) {
                    if (MODE == 0) { bv[bj][0] = *(const f32x4*)(basef + off + bj * HALF); bv[bj][1] = *(const f32x4*)(basef + off + bj * HALF + 4); }
                    else { const u32x4 w = *(const u32x4*)(hb + off + bj * HALF);
                        bv[bj][0] = (f32x4){__builtin_bit_cast(float, w.x << 16), __builtin_bit_cast(float, w.x & 0xffff0000u), __builtin_bit_cast(float, w.y << 16), __builtin_bit_cast(float, w.y & 0xffff0000u)};
                        bv[bj][1] = (f32x4){__builtin_bit_cast(float, w.z << 16), __builtin_bit_cast(float, w.z & 0xffff0000u), __builtin_bit_cast(float, w.w << 16), __builtin_bit_cast(float, w.w & 0xffff0000u)}; } }
#pragma unroll
                for (int bj = 0; bj < 2; ++bj) { const f32x4 h0 = bv[bj][0] + acc[ai][bj][m][0], h1 = bv[bj][1] + acc[ai][bj][m][1];
                    if (MODE == 2) { *(f32x4*)(out + off + bj * HALF) = h0; *(f32x4*)(out + off + bj * HALF + 4) = h1; }
                    else { u32x4 w; w.x = cvtpk(h0[0], h0[1]); w.y = cvtpk(h0[2], h0[3]); w.z = cvtpk(h1[0], h1[1]); w.w = cvtpk(h1[2], h1[3]); *(u32x4*)(hb + off + bj * HALF) = w;
                        s += ((h0[0] * h0[0] + h0[1] * h0[1]) + (h0[2] * h0[2] + h0[3] * h0[3])) + ((h1[0] * h1[0] + h1[1] * h1[1]) + (h1[2] * h1[2] + h1[3] * h1[3])); } }
                if (MODE != 2) { s += __shfl_xor(s, 16); s += __shfl_xor(s, 32); if (fq == 0) P[rl * 4 + wc] = s; }
                asm volatile("" ::: "memory");
            }
        if (MODE != 2) {
            asm volatile("s_waitcnt lgkmcnt(0)" ::: "memory"); __builtin_amdgcn_s_barrier(); asm volatile("" ::: "memory");
            const int t = wid * 64 + lane;
            if (t < 256) { const f32x4 p = *(const LAS f32x4*)(P + t * 4); ssp[(size_t)(u.pm * BM + t) * 4 + u.pn] = (p[0] + p[1]) + (p[2] + p[3]); }
        }
    }
};

template <class Epi, class Sched, bool ALIGN_EPI = false, bool SP2 = false, bool FP8 = false>
__device__ __forceinline__ void gemm_phase(LAS unsigned char* lds, const Gemm g, const Sched& S, const Epi& E) {
    const int tid = threadIdx.x, wid = __builtin_amdgcn_readfirstlane(tid >> 6), lane = tid & 63, wr = wid >> 2, wc = wid & 3, fr = lane & 15, fq = lane >> 4;
    const int K = g.K, nt = K / BK;
    unsigned voffA[2], voffB[2];
#pragma unroll
    for (int i = 0; i < 2; ++i) { int R, C; stage_rc(tid * 16 + i * 8192, R, C); const int Rb = Epi::PERM ? ((R & ~31) + perm32(R & 31)) : R;
        voffA[i] = (unsigned)(R * K + C) * 2u; voffB[i] = (unsigned)(Rb * K + C) * 2u; }
    const size_t kstep = (size_t)(BK * 2);
    const size_t hstep = (size_t)HALF * K * 2;
    const size_t tstep = 2 * hstep;
    const unsigned ldsw = (unsigned)wid * 1024u;
    const int aoff = lds_byte(wr * 64 + fr, fq * 8), boff = lds_byte(wc * 32 + fr, fq * 8);
#define PG8_SA(b, h) (((b) * 2 + (h)) * HTB)
#define PG8_SB(b, h) ((4 + (b) * 2 + (h)) * HTB)
#define PG8_STAGE(bufoff, gbase, voff) do { _Pragma("unroll") for (int _i = 0; _i < 2; ++_i) \
        __builtin_amdgcn_global_load_lds((const unsigned*)((const char*)(gbase) + (voff)[_i]), (LAS unsigned*)(lds + (bufoff) + ldsw + _i * 8192), 16, 0, 0); } while (0)
#define PG8_LD8(d8, p_) do { const u32x4 l_ = *(const LAS u32x4*)(p_), h_ = *(const LAS u32x4*)((p_) + 1024); \
        d8[0] = (int)l_.x; d8[1] = (int)l_.y; d8[2] = (int)l_.z; d8[3] = (int)l_.w; d8[4] = (int)h_.x; d8[5] = (int)h_.y; d8[6] = (int)h_.z; d8[7] = (int)h_.w; } while (0)
#define PG8_LDA(dst, b, h) do { _Pragma("unroll") for (int m = 0; m < 4; ++m) PG8_LD8(dst[m], lds + PG8_SA(b, h) + aoff + m * 2048); } while (0)
#define PG8_LDB(dst, b, h) do { _Pragma("unroll") for (int n = 0; n < 2; ++n) PG8_LD8(dst[n], lds + PG8_SB(b, h) + boff + n * 2048); } while (0)
#define PG8_F0(x) __builtin_bit_cast(bf16x8, __builtin_shufflevector(x, x, 0, 1, 2, 3))
#define PG8_F1(x) __builtin_bit_cast(bf16x8, __builtin_shufflevector(x, x, 4, 5, 6, 7))
#define PG8_MMA(ai, bj, At, Bt) do { __builtin_amdgcn_s_setprio(1); _Pragma("unroll") for (int m = 0; m < 4; ++m) _Pragma("unroll") for (int n = 0; n < 2; ++n) { \
        if constexpr (FP8) asm volatile("v_mfma_scale_f32_16x16x128_f8f6f4 %0, %1, %2, %0, %3, %4 op_sel_hi:[0,0,0]" : "+v"(acc[ai][bj][m][n]) : "v"(Bt[n]), "v"(At[m]), "v"(scw_), "v"(sc1_));        \
        else { acc[ai][bj][m][n] = __builtin_amdgcn_mfma_f32_16x16x32_bf16(PG8_F0(Bt[n]), PG8_F0(At[m]), acc[ai][bj][m][n], 0, 0, 0); \
               acc[ai][bj][m][n] = __builtin_amdgcn_mfma_f32_16x16x32_bf16(PG8_F1(Bt[n]), PG8_F1(At[m]), acc[ai][bj][m][n], 0, 0, 0); } } \
        __builtin_amdgcn_s_setprio(0); } while (0)
#define PG8_WAIT_V(n) asm volatile("s_waitcnt vmcnt(" #n ")" ::: "memory")
#define PG8_WAIT_L(n) asm volatile("s_waitcnt lgkmcnt(" #n ")" ::: "memory")
#define PG8_BAR __builtin_amdgcn_s_barrier()
#define PG8_SCHED __builtin_amdgcn_sched_barrier(0)
    Unit cur, nxt; int ui = 0;
    if (!S.next(0, cur)) return;
    f32x4 acc[2][2][4][2];
#pragma unroll
    for (int a = 0; a < 2; ++a)
#pragma unroll
        for (int b = 0; b < 2; ++b)
#pragma unroll
            for (int m = 0; m < 4; ++m)
#pragma unroll
                for (int n = 0; n < 2; ++n) acc[a][b][m][n] = (f32x4){0.f, 0.f, 0.f, 0.f};
    i32x8 At[4], B0[2], B1[2]; const int sc1_ = 0x7F7F7F7F, scw_ = 0x7A7A7A7A;
    const char* cA = (const char*)g.A + (size_t)cur.pm * tstep; const char* cB = (const char*)g.Bt + (size_t)cur.pn * tstep;
    if constexpr (SP2) {
        PG8_STAGE(PG8_SB(0, 0), cB, voffB); PG8_STAGE(PG8_SB(0, 1), cB + hstep, voffB); PG8_STAGE(PG8_SA(0, 0), cA, voffA); PG8_STAGE(PG8_SA(0, 1), cA + hstep, voffA);
        if (wr == 1) PG8_BAR;
        PG8_WAIT_V(2); PG8_BAR;
        PG8_STAGE(PG8_SB(1, 0), cB + kstep, voffB); PG8_STAGE(PG8_SA(1, 0), cA + kstep, voffA); PG8_STAGE(PG8_SB(1, 1), cB + hstep + kstep, voffB);
        PG8_WAIT_V(6); PG8_BAR;
    } else {
        PG8_STAGE(PG8_SB(0, 0), cB, voffB); PG8_STAGE(PG8_SA(0, 0), cA, voffA); PG8_STAGE(PG8_SB(0, 1), cB + hstep, voffB); PG8_STAGE(PG8_SA(0, 1), cA + hstep, voffA);
        if (wr == 1) PG8_BAR;
        PG8_WAIT_V(4); PG8_BAR;
        PG8_STAGE(PG8_SB(1, 0), cB + kstep, voffB); PG8_STAGE(PG8_SA(1, 0), cA + kstep, voffA); PG8_STAGE(PG8_SB(1, 1), cB + hstep + kstep, voffB);
        PG8_WAIT_V(6); PG8_BAR;
    }
    for (;;) {
        const bool has_next = S.next(ui + 1, nxt);
        const char* nA = has_next ? (const char*)g.A + (size_t)nxt.pm * tstep : cA; const char* nB = has_next ? (const char*)g.Bt + (size_t)nxt.pn * tstep : cB;
#pragma clang loop unroll(disable)
        for (int t = 0; t < nt; t += 2) {
            const bool last = (t == nt - 2);
            const char* a1 = cA + (size_t)(t + 1) * kstep;
            const char* a2 = last ? nA : cA + (size_t)(t + 2) * kstep; const char* b2 = last ? nB : cB + (size_t)(t + 2) * kstep;
            const char* a3 = a2 + kstep; const char* b3 = b2 + kstep;
            if constexpr (SP2) {
            PG8_LDB(B0, 0, 0); PG8_LDB(B1, 0, 1); PG8_SCHED; PG8_LDA(At, 0, 0); PG8_STAGE(PG8_SA(1, 1), a1 + hstep, voffA);
            PG8_WAIT_V(8); PG8_WAIT_L(0); PG8_BAR; PG8_MMA(0, 0, At, B0); PG8_MMA(0, 1, At, B1); PG8_BAR; PG8_SCHED;
            PG8_LDA(At, 0, 1); PG8_STAGE(PG8_SB(0, 0), b2, voffB); PG8_STAGE(PG8_SB(0, 1), b2 + hstep, voffB); PG8_STAGE(PG8_SA(0, 0), a2, voffA);
            PG8_WAIT_V(8); PG8_WAIT_L(0); PG8_BAR; PG8_MMA(1, 0, At, B0); PG8_MMA(1, 1, At, B1); PG8_BAR; PG8_SCHED;
            PG8_LDB(B0, 1, 0); PG8_LDB(B1, 1, 1); PG8_SCHED; PG8_LDA(At, 1, 0); PG8_STAGE(PG8_SA(0, 1), a2 + hstep, voffA);
            PG8_WAIT_V(8); PG8_WAIT_L(0); PG8_BAR; PG8_MMA(0, 0, At, B0); PG8_MMA(0, 1, At, B1); PG8_BAR; PG8_SCHED;
            PG8_LDA(At, 1, 1); PG8_STAGE(PG8_SB(1, 0), b3, voffB); PG8_STAGE(PG8_SB(1, 1), b3 + hstep, voffB); PG8_STAGE(PG8_SA(1, 0), a3, voffA);
            PG8_WAIT_V(8); PG8_WAIT_L(0); PG8_BAR; PG8_MMA(1, 0, At, B0); PG8_MMA(1, 1, At, B1); PG8_BAR; PG8_SCHED;
            } else {
            PG8_LDB(B0, 0, 0); PG8_SCHED; PG8_LDA(At, 0, 0); PG8_STAGE(PG8_SA(1, 1), a1 + hstep, voffA);
            PG8_WAIT_L(8); PG8_BAR; PG8_WAIT_L(0); PG8_MMA(0, 0, At, B0); PG8_BAR; PG8_SCHED;
            PG8_LDB(B1, 0, 1); PG8_STAGE(PG8_SB(0, 0), b2, voffB);
            PG8_BAR; PG8_WAIT_L(0); PG8_MMA(0, 1, At, B1); PG8_BAR;
            PG8_LDA(At, 0, 1); PG8_STAGE(PG8_SA(0, 0), a2, voffA);
            PG8_BAR; PG8_WAIT_L(0); PG8_MMA(1, 0, At, B0); PG8_BAR; PG8_SCHED;
            PG8_STAGE(PG8_SB(0, 1), b2 + hstep, voffB);
            PG8_WAIT_V(6); PG8_BAR; PG8_MMA(1, 1, At, B1); PG8_BAR;
            PG8_LDB(B0, 1, 0); PG8_SCHED; PG8_LDA(At, 1, 0); PG8_STAGE(PG8_SA(0, 1), a2 + hstep, voffA);
            PG8_WAIT_L(8); PG8_BAR; PG8_WAIT_L(0); PG8_MMA(0, 0, At, B0); PG8_BAR; PG8_SCHED;
            PG8_LDB(B1, 1, 1); PG8_STAGE(PG8_SB(1, 0), b3, voffB);
            PG8_BAR; PG8_WAIT_L(0); PG8_MMA(0, 1, At, B1); PG8_BAR;
            PG8_LDA(At, 1, 1); PG8_STAGE(PG8_SA(1, 0), a3, voffA);
            PG8_BAR; PG8_WAIT_L(0); PG8_MMA(1, 0, At, B0); PG8_BAR; PG8_SCHED;
            PG8_STAGE(PG8_SB(1, 1), b3 + hstep, voffB);
            PG8_WAIT_V(6); PG8_BAR; PG8_MMA(1, 1, At, B1); PG8_BAR;
            }
        }
        if constexpr (ALIGN_EPI) { if (wr == 0) PG8_BAR; }
        if constexpr (!Epi::AFTER_DRAIN) { E(acc, cur, wr, wc, fr, fq); }
        if (!has_next) break;
#pragma unroll
        for (int a = 0; a < 2; ++a)
#pragma unroll
            for (int b = 0; b < 2; ++b)
#pragma unroll
                for (int m = 0; m < 4; ++m)
#pragma unroll
                    for (int n = 0; n < 2; ++n) acc[a][b][m][n] = (f32x4){0.f, 0.f, 0.f, 0.f};
        cur = nxt; cA = nA; cB = nB; ++ui;
        if constexpr (ALIGN_EPI) { if (wr == 1) PG8_BAR; }
    }
    PG8_WAIT_V(0);
    if constexpr (!ALIGN_EPI) { if (wr == 0) PG8_BAR; }
    PG8_BAR;
    if constexpr (Epi::AFTER_DRAIN) { E.fused(acc, cur, wr, wc, fr, fq, lds, wid, lane); }
#undef PG8_SA
#undef PG8_SB
#undef PG8_STAGE
#undef PG8_LDA
#undef PG8_LDB
#undef PG8_MMA
#undef PG8_LD8
#undef PG8_F0
#undef PG8_F1
#undef PG8_WAIT_V
#undef PG8_WAIT_L
#undef PG8_BAR
#undef PG8_SCHED
}
}

namespace att {
constexpr int KB_OFF = 0, VB_OFF = 32768, TBL_OFF = 65536, OST_OFF = 68608, WS_OFF = OST_OFF + 8 * 4096, LDS_END = WS_OFF + 8 * 128;
__device__ __forceinline__ int crow(int r, int hi) { return (r & 3) + 8 * (r >> 2) + 4 * hi; }
#define ATT_WAIT_BAR() asm volatile("s_waitcnt vmcnt(0) lgkmcnt(0)\n\ts_barrier" ::: "memory")
__device__ __forceinline__ int lane_id_v() { int l; asm volatile("v_mbcnt_lo_u32_b32 %0, -1, 0\n\tv_mbcnt_hi_u32_b32 %0, -1, %0" : "=v"(l)); return l; }
__device__ __forceinline__ void glds16(const void* gsrc, unsigned lds_dst) { unsigned keep;
    asm volatile("s_mov_b32 %0, m0\n\ts_mov_b32 m0, %2\n\ts_nop 0\n\tglobal_load_lds_dwordx4 %1, off\n\ts_mov_b32 m0, %0" : "=&s"(keep) : "v"(gsrc), "s"(lds_dst) : "memory"); }

struct StreamDesc {
    const bf16_t* Q; const bf16_t* K; const bf16_t* V;
    int i0, R;
    const float* tblg;
    bf16_t* O; int o_row0, o_rstride;
    float* L;
};
constexpr int S_KB = 0, S_VB = 49152, S_TBL = 98304, S_OST = 101376, S_WS = S_OST + 8 * 4096, S_END = S_WS + 8 * 128;
__device__ __forceinline__ void stream(LAS unsigned char* lds, const StreamDesc& U) {
    const int tid = threadIdx.x, lane = tid & 63, r32 = lane & 31, hi = lane >> 5; const int wid = __builtin_amdgcn_readfirstlane(tid >> 6);
    LAS float* tbl = (LAS float*)(lds + S_TBL);
    { int t_ = tid; asm volatile("" : "+v"(t_));
      for (int i = t_; i < TBLA_N / 4; i += 512) ((LAS f32x4*)tbl)[i] = ((const f32x4*)U.tblg)[i]; }
    const unsigned lds0 = (unsigned)(uintptr_t)lds;
#define ATT_DMA(t) do { const int l_ = lane_id_v(); const int sl_ = (t) % 6; \
        glds16((const unsigned char*)U.K + ((size_t)(t) * 64 + l_) * 64 + (wid & 3) * 16, (unsigned)__builtin_amdgcn_readfirstlane((int)(lds0 + S_KB + sl_ * 8192 + (wid & 3) * 1024))); \
        glds16(U.V + (size_t)(16 * (wid & 3) + (l_ >> 2)) * 64 + (wid >> 2) * 32 + (l_ & 3) * 8 + (size_t)(t) * 4096, (unsigned)__builtin_amdgcn_readfirstlane((int)(lds0 + S_VB + sl_ * 8192 + wid * 1024))); } while (0)
    const int t_first = (U.i0 >> 1) - 2 > 0 ? (U.i0 >> 1) - 2 : 0, t_last = (U.i0 >> 1) + 4 * U.R - 1;
    int r = 0;
    int qt = U.i0 + wid;
#define BF_LO(x) __builtin_bit_cast(float, (unsigned)(unsigned short)(x) << 16)
#define ST_Q8(dst8, src) do { _Pragma("unroll") for (int d0 = 0; d0 < 4; ++d0) { const bf16x8 a_ = src[d0]; \
        dst8[2 * d0] = (int)pk4_fp8(BF_LO(a_[0]), BF_LO(a_[1]), BF_LO(a_[2]), BF_LO(a_[3])); dst8[2 * d0 + 1] = (int)pk4_fp8(BF_LO(a_[4]), BF_LO(a_[5]), BF_LO(a_[6]), BF_LO(a_[7])); } } while (0)
#define MFMA8(a, b, c) __builtin_amdgcn_mfma_scale_f32_32x32x64_f8f6f4(a, b, c, 0, 0, 0, 0x7F7F7F7F, 0, 0x7F7F7F7F)
    i32x8 q8;
    { bf16x8 q0_[4];
#pragma unroll
      for (int d0 = 0; d0 < 4; ++d0) q0_[d0] = *(const bf16x8*)(U.Q + (size_t)(qt * 32 + r32) * 64 + d0 * 16 + hi * 8);
      ST_Q8(q8, q0_); }
#define ST_QDMA(qtile) do { const int l_ = lane_id_v(); _Pragma("unroll") for (int d0 = 0; d0 < 4; ++d0) \
        glds16(U.Q + (size_t)((qtile) * 32 + (l_ & 31)) * 64 + d0 * 16 + (l_ >> 5) * 8, (unsigned)__builtin_amdgcn_readfirstlane((int)(lds0 + S_OST + wid * 4096 + d0 * 1024))); } while (0)
    if (U.R > 1) ST_QDMA(qt + 8);
    ATT_DMA(t_first); ATT_DMA(t_first + 1);
    f32x16 o[2], ol; o[0] = (f32x16){0.f, 0.f, 0.f, 0.f, 0.f, 0.f, 0.f, 0.f, 0.f, 0.f, 0.f, 0.f, 0.f, 0.f, 0.f, 0.f}; o[1] = o[0]; ol = o[0];
    const int vb0 = (int)(unsigned)(uintptr_t)(lds + S_VB) + ((lane >> 4) & 1) * 32 + (lane & 3) * 8 + (4 * hi + ((lane & 15) >> 2)) * 64;
    const bf16x8 ones = {0x3F80, 0x3F80, 0x3F80, 0x3F80, 0x3F80, 0x3F80, 0x3F80, 0x3F80};
    LAS bf16_t* stg = (LAS bf16_t*)(lds + S_OST) + wid * 2048;
    LAS float* wsl = (LAS float*)(lds + S_WS) + wid * 32;
    ATT_WAIT_BAR();
#define ST_TILEH(tt, H0, H1) do { const int kbase_ = (tt) * 64, qrow_ = qt * 32 + r32, sl_ = (tt) % 6; \
        const LAS float* tp_ = tbl + (383 - (qrow_ - kbase_) + 4 * hi); f32x16 p0, p1; \
        _Pragma("unroll") for (int rr = 0; rr < 16; ++rr) { const int cc = (rr & 3) + 8 * (rr >> 2); if (H0) p0[rr] = tp_[cc]; if (H1) p1[rr] = tp_[cc + 32]; } \
        const LAS unsigned char* kb_ = lds + S_KB + sl_ * 8192 + r32 * 16 + hi * 8; \
        if (H0) { i32x8 k_; _Pragma("unroll") for (int d0 = 0; d0 < 4; ++d0) { const u32x2 x_ = *(const LAS u32x2*)(kb_ + d0 * 1024); k_[2 * d0] = (int)x_.x; k_[2 * d0 + 1] = (int)x_.y; } p0 = MFMA8(k_, q8, p0); } \
        if (H1) { i32x8 k_; _Pragma("unroll") for (int d0 = 0; d0 < 4; ++d0) { const u32x2 x_ = *(const LAS u32x2*)(kb_ + d0 * 1024 + 512); k_[2 * d0] = (int)x_.x; k_[2 * d0 + 1] = (int)x_.y; } p1 = MFMA8(k_, q8, p1); } \
        _Pragma("unroll") for (int rr = 0; rr < 16; ++rr) { if (H0) p0[rr] = __builtin_amdgcn_exp2f(p0[rr]); if (H1) p1[rr] = __builtin_amdgcn_exp2f(p1[rr]); } \
        u32x4 pw[4]; \
        _Pragma("unroll") for (int k = 0; k < 2; ++k) { \
            if (H0) pw[k] = (u32x4){cvtpk(p0[8 * k], p0[8 * k + 1]), cvtpk(p0[8 * k + 2], p0[8 * k + 3]), cvtpk(p0[8 * k + 4], p0[8 * k + 5]), cvtpk(p0[8 * k + 6], p0[8 * k + 7])}; \
            if (H1) pw[2 + k] = (u32x4){cvtpk(p1[8 * k], p1[8 * k + 1]), cvtpk(p1[8 * k + 2], p1[8 * k + 3]), cvtpk(p1[8 * k + 4], p1[8 * k + 5]), cvtpk(p1[8 * k + 6], p1[8 * k + 7])}; } \
        _Pragma("unroll") for (int ks = (H0) ? 0 : 2; ks < ((H1) ? 4 : 2); ++ks) ol = __builtin_amdgcn_mfma_f32_32x32x16_bf16(__builtin_bit_cast(bf16x8, pw[ks]), ones, ol, 0, 0, 0); \
        const int vb_ = vb0 + sl_ * 8192; \
        _Pragma("unroll") for (int d0 = 0; d0 < 2; ++d0) { s16x4 vlo[4], vhi[4]; \
            _Pragma("unroll") for (int ks = (H0) ? 0 : 2; ks < ((H1) ? 4 : 2); ++ks) { vlo[ks] = __builtin_bit_cast(s16x4, __builtin_amdgcn_ds_read_tr16_b64_v4i16((LAS s16x4*)(uintptr_t)(unsigned)(vb_ + d0 * 4096 + ks * 1024))); \
                                                             vhi[ks] = __builtin_bit_cast(s16x4, __builtin_amdgcn_ds_read_tr16_b64_v4i16((LAS s16x4*)(uintptr_t)(unsigned)(vb_ + d0 * 4096 + ks * 1024 + 512))); } \
            _Pragma("unroll") for (int ks = (H0) ? 0 : 2; ks < ((H1) ? 4 : 2); ++ks) { const bf16x8 vf = (bf16x8){vlo[ks][0], vlo[ks][1], vlo[ks][2], vlo[ks][3], vhi[ks][0], vhi[ks][1], vhi[ks][2], vhi[ks][3]}; \
                o[d0] = __builtin_amdgcn_mfma_f32_32x32x16_bf16(__builtin_bit_cast(bf16x8, pw[ks]), vf, o[d0], 0, 0, 0); } } } while (0)
#define ST_TILE(tt) ST_TILEH(tt, true, true)
    int pend_qt = -1;
#define ST_FLUSH() do { if (pend_qt >= 0) { const int lf_ = lane_id_v();        \
        { const int rf_ = lf_ & 31; const float lv = wsl[rf_]; float* lp = U.L + (size_t)(U.o_row0 + (pend_qt * 32 + rf_) * U.o_rstride) * 8; if (lf_ < 32) *lp = lv; } \
        _Pragma("unroll") for (int i = 0; i < 4; ++i) { const int row = i * 8 + (lf_ >> 3), ch = lf_ & 7; const u32x4 v = *(const LAS u32x4*)((LAS bf16_t*)(lds + S_OST) + wid * 2048 + row * 64 + ch * 8); \
            *(u32x4*)(U.O + (size_t)(U.o_row0 + (pend_qt * 32 + row) * U.o_rstride) * 512 + ch * 8) = v; } \
        if (r + 1 < U.R) { asm volatile("s_waitcnt lgkmcnt(0)" ::: "memory"); ST_QDMA(qt + 8); } \
        pend_qt = -1; } } while (0)
    for (int t = t_first; t < t_last; t += 2) {
        if (t + 2 < t_last) { ATT_DMA(t + 2); ATT_DMA(t + 3); }
        ST_FLUSH();
        if (r < U.R) {
            const int wend = qt >> 1;
            const bool a0 = (t >= wend - 2) && (t <= wend), a1 = (t + 1 >= wend - 2) && (t + 1 <= wend);
            const bool odd = qt & 1;
            if (a0 && a1) {
                if (t == wend - 2) { if (odd) { ST_TILEH(t, false, true); ST_TILE(t + 1); } else { ST_TILE(t); ST_TILE(t + 1); } }
                else { if (!odd) { ST_TILE(t); ST_TILEH(t + 1, true, false); } else { ST_TILE(t); ST_TILE(t + 1); } } }
            else if (a0) { if (!odd && t == wend) ST_TILEH(t, true, false); else ST_TILE(t); }
            else if (a1) { if (odd && t + 1 == wend - 2) ST_TILEH(t + 1, false, true); else ST_TILE(t + 1); }
            if (wend == t || wend == t + 1) {
                if (r + 1 < U.R) {
                    bf16x8 qx_[4];
#pragma unroll
                    for (int d0 = 0; d0 < 4; ++d0) qx_[d0] = *(const LAS bf16x8*)(lds + S_OST + wid * 4096 + d0 * 1024 + lane_id_v() * 16);
                    asm volatile("s_waitcnt lgkmcnt(0)" ::: "memory");
                    ST_Q8(q8, qx_); }
#pragma unroll
                for (int rr = 0; rr < 16; ++rr) { const int orow = crow(rr, hi);
#pragma unroll
                    for (int d0 = 0; d0 < 2; ++d0) stg[orow * 64 + d0 * 32 + r32] = (bf16_t)(cvtpk(o[d0][rr], 0.f) & 0xffffu);
                    if (r32 == 0) wsl[orow] = ol[rr]; }
                pend_qt = qt; ++r; qt += 8;
                o[0] = (f32x16){0.f, 0.f, 0.f, 0.f, 0.f, 0.f, 0.f, 0.f, 0.f, 0.f, 0.f, 0.f, 0.f, 0.f, 0.f, 0.f}; o[1] = o[0]; ol = o[0];
            }
        }
        ATT_WAIT_BAR();
    }
    ST_FLUSH();
    asm volatile("s_waitcnt vmcnt(0)" ::: "memory");
#undef ST_FLUSH
#undef ST_QDMA
#undef ST_Q8
#undef BF_LO
#undef MFMA8
#undef ATT_DMA
#undef ST_TILE
#undef ST_TILEH
}

constexpr int D_KB = 0, D_VB = 49152, D_TBL = 98304, D_KM = D_TBL + 17408, D_OST = D_KM + 8192, D_END = D_OST + 8 * 4096;
__device__ __forceinline__ void moba_pair(LAS unsigned char* lds, int p, const bf16_t* Qs, const bf16_t* Ks, const bf16_t* Vs, const float* tblg, const float* kmp0, const float* kmp1, bf16_t* O) {
    const int tid = threadIdx.x, lane = tid & 63, r32 = lane & 31, hi = lane >> 5; const int wid = __builtin_amdgcn_readfirstlane(tid >> 6);
    LAS float* tbl = (LAS float*)(lds + D_TBL);
    const int qbA = 2 * p, qbB = 2 * p + 1, NT = 8 * p + 8, NTA = 8 * p + 4;
    const unsigned char* K8 = (const unsigned char*)Ks;
    const unsigned char* V8 = (const unsigned char*)Vs;
    const unsigned lds0 = (unsigned)(uintptr_t)lds;
    const unsigned char* const KV8 = (wid < 4) ? K8 : V8; const unsigned kvl = lds0 + ((wid < 4) ? D_KB : D_VB) + (wid & 3) * 1024;
#define MD_DMA(t) do { int l_ = lane; asm volatile("" : "+v"(l_)); \
        glds16(KV8 + ((size_t)(t) * 64 + l_) * 64 + (wid & 3) * 16, (unsigned)__builtin_amdgcn_readfirstlane((int)(kvl + ((t) % 12) * 4096))); } while (0)
    int tq_ = tid; asm volatile("" : "+v"(tq_));
    for (int i = tq_; i < TBLB_N / 4; i += 512) ((LAS f32x4*)tbl)[i] = ((const f32x4*)tblg)[i];
    {   LAS bf16_t* kmh = (LAS bf16_t*)(lds + D_KM); LAS bf16_t* kml = kmh + 32 * 64;
        for (int i = tq_; i < 32 * 64; i += 512) { const int j = i >> 6, d = i & 63; float x = 0.f;
            if (j < qbB) x = (kmp0[(size_t)j * 1024 + d] + kmp1[(size_t)j * 1024 + d]) * (1.f / 256.f);
            const unsigned hb = cvtpk(x, 0.f) & 0xffffu; const float xl = x - bf2f((unsigned short)hb);
            kmh[i] = (bf16_t)hb; kml[i] = (bf16_t)(cvtpk(xl, 0.f) & 0xffffu); } }
    const int qt = (wid < 4) ? wid : 11 - wid;
    const int qrowA = qbA * 256 + qt * 32 + r32, qrowB = qrowA + 256;
    bf16x8 qrA[4], qrB[4];
#pragma unroll
    for (int d0 = 0; d0 < 4; ++d0) { qrA[d0] = *(const bf16x8*)(Qs + (size_t)qrowA * 64 + d0 * 16 + hi * 8); qrB[d0] = *(const bf16x8*)(Qs + (size_t)qrowB * 64 + d0 * 16 + hi * 8); }
    MD_DMA(0); MD_DMA(1); MD_DMA(2); MD_DMA(3);
    ATT_WAIT_BAR();
    MD_DMA(4); MD_DMA(5); MD_DMA(6); MD_DMA(7);
    unsigned selA = 0u, selB = 0u;
#define MD_GATE(SEL, QR, QB) do { f32x16 g0 = {0.f, 0.f, 0.f, 0.f, 0.f, 0.f, 0.f, 0.f, 0.f, 0.f, 0.f, 0.f, 0.f, 0.f, 0.f, 0.f}; \
        const LAS unsigned char* kb_ = lds + D_KM + r32 * 128 + hi * 16; \
        _Pragma("unroll") for (int d0 = 0; d0 < 4; ++d0) { const bf16x8 ah = *(const LAS bf16x8*)(kb_ + d0 * 32), al = *(const LAS bf16x8*)(kb_ + 4096 + d0 * 32); \
            g0 = __builtin_amdgcn_mfma_f32_32x32x16_bf16(ah, QR[d0], g0, 0, 0, 0); g0 = __builtin_amdgcn_mfma_f32_32x32x16_bf16(al, QR[d0], g0, 0, 0, 0); } \
        float gt[16]; \
        _Pragma("unroll") for (int r = 0; r < 8; ++r) { const float mine = g0[r], oth = __shfl_xor(mine, 32); const int jm = (r & 3) + 8 * (r >> 2); gt[jm] = hi ? oth : mine; gt[jm + 4] = hi ? mine : oth; } \
        _Pragma("unroll") for (int rep = 0; rep < 3; ++rep) { float best = -__builtin_inff(); int bi = -1; \
            _Pragma("unroll") for (int j = 0; j < 16; ++j) { const bool ok = (j < (QB)) && !((SEL >> j) & 1u) && (gt[j] > best); if (ok) { best = gt[j]; bi = j; } } \
            if (bi >= 0) SEL |= 1u << bi; } \
        SEL |= 1u << (QB); } while (0)
    MD_GATE(selA, qrA, qbA);
    MD_GATE(selB, qrB, qbB);
    i32x8 q8A, q8B;
#pragma unroll
    for (int d0 = 0; d0 < 4; ++d0) {
#define BF_LO(x) __builtin_bit_cast(float, (unsigned)(unsigned short)(x) << 16)
        const bf16x8 a_ = qrA[d0], b_ = qrB[d0];
#define BF_L4(x) (4.f * BF_LO(x))
        const unsigned a0_ = pk4_fp8(BF_L4(a_[0]), BF_L4(a_[1]), BF_L4(a_[2]), BF_L4(a_[3])), a1_ = pk4_fp8(BF_L4(a_[4]), BF_L4(a_[5]), BF_L4(a_[6]), BF_L4(a_[7]));
        const unsigned b0_ = pk4_fp8(BF_L4(b_[0]), BF_L4(b_[1]), BF_L4(b_[2]), BF_L4(b_[3])), b1_ = pk4_fp8(BF_L4(b_[4]), BF_L4(b_[5]), BF_L4(b_[6]), BF_L4(b_[7]));
#undef BF_L4
#undef BF_LO
        q8A[2 * d0] = (int)a0_; q8A[2 * d0 + 1] = (int)a1_; q8B[2 * d0] = (int)b0_; q8B[2 * d0 + 1] = (int)b1_; }
#define QA q8A
#define QB_ q8B
#define MFMA8(a, b, c) __builtin_amdgcn_mfma_scale_f32_32x32x64_f8f6f4(a, b, c, 0, 0, 0, 0x7F7F7F7F, 0, 0x7F7F7F7F)
    const int vb0 = (int)(unsigned)(uintptr_t)(lds + D_VB) + ((lane >> 4) & 1) * 32 + (lane & 3) * 8 + (4 * hi + ((lane & 15) >> 2)) * 64;
    f32x16 lacc = (f32x16){0.f, 0.f, 0.f, 0.f, 0.f, 0.f, 0.f, 0.f, 0.f, 0.f, 0.f, 0.f, 0.f, 0.f, 0.f, 0.f};
    const int o1A_ = (r32 < 16) ? 0x38383838 : 0, o1B_ = (r32 < 16) ? 0 : 0x38383838;
    const i32x8 onesA = {o1A_, o1A_, o1A_, o1A_, o1A_, o1A_, o1A_, o1A_}, onesB = {o1B_, o1B_, o1B_, o1B_, o1B_, o1B_, o1B_, o1B_};
    f32x16 oA[2], oB[2]; oA[0] = (f32x16){0.f, 0.f, 0.f, 0.f, 0.f, 0.f, 0.f, 0.f, 0.f, 0.f, 0.f, 0.f, 0.f, 0.f, 0.f, 0.f}; oA[1] = oA[0]; oB[0] = oA[0]; oB[1] = oA[0];
#define MD_QK(P0, P1, SEL, QROW, QR, t) do { const int kb_ = 64 * (t); const bool sel_ = (SEL >> ((t) >> 2)) & 1u; \
        const int base_ = sel_ ? (4095 - (QROW - kb_) + 4 * hi) : (4096 + 4 * hi); const LAS float* tp_ = tbl + base_; \
        _Pragma("unroll") for (int r = 0; r < 16; ++r) { const int cc = (r & 3) + 8 * (r >> 2); P0[r] = tp_[cc]; P1[r] = tp_[cc + 32]; } \
        const LAS unsigned char* kq_ = lds + D_KB + ((t) % 12) * 4096 + r32 * 16 + hi * 8; \
        i32x8 k0_, k1_; \
        _Pragma("unroll") for (int d0 = 0; d0 < 4; ++d0) { const u32x2 x0_ = *(const LAS u32x2*)(kq_ + d0 * 1024), x1_ = *(const LAS u32x2*)(kq_ + d0 * 1024 + 512); \
            k0_[2 * d0] = (int)x0_.x; k0_[2 * d0 + 1] = (int)x0_.y; k1_[2 * d0] = (int)x1_.x; k1_[2 * d0 + 1] = (int)x1_.y; } \
        P0 = MFMA8(k0_, QR, P0); P1 = MFMA8(k1_, QR, P1); } while (0)
#define U8X4(a, b, c, d) __builtin_amdgcn_cvt_pk_u8_f32(d, 3, __builtin_amdgcn_cvt_pk_u8_f32(c, 2, __builtin_amdgcn_cvt_pk_u8_f32(b, 1, __builtin_amdgcn_cvt_pk_u8_f32(a, 0, 0u))))
#define MD_EXP(PW, P0, P1, OL) do { \
        _Pragma("unroll") for (int g = 0; g < 4; ++g) { const unsigned x_ = U8X4(P0[4 * g], P0[4 * g + 1], P0[4 * g + 2], P0[4 * g + 3]), y_ = U8X4(P1[4 * g], P1[4 * g + 1], P1[4 * g + 2], P1[4 * g + 3]); \
            const u32x2 sw_ = __builtin_amdgcn_permlane32_swap(x_, y_, false, false); PW[2 * g] = (int)sw_.x; PW[2 * g + 1] = (int)sw_.y; } \
        lacc = MFMA8P(PW, OL, lacc); } while (0)
#define MD_EXPX(PW, P0, P1, OL) do { \
        _Pragma("unroll") for (int r = 0; r < 16; ++r) { P0[r] = __builtin_amdgcn_exp2f(P0[r] * 0.25f - 15.f); P1[r] = __builtin_amdgcn_exp2f(P1[r] * 0.25f - 15.f); } \
        _Pragma("unroll") for (int g = 0; g < 4; ++g) { const unsigned x_ = pk4_bf8(P0[4 * g], P0[4 * g + 1], P0[4 * g + 2], P0[4 * g + 3]), y_ = pk4_bf8(P1[4 * g], P1[4 * g + 1], P1[4 * g + 2], P1[4 * g + 3]); \
            const u32x2 sw_ = __builtin_amdgcn_permlane32_swap(x_, y_, false, false); PW[2 * g] = (int)sw_.x; PW[2 * g + 1] = (int)sw_.y; } \
        lacc = MFMA8P(PW, OL, lacc); } while (0)
#define MFMA8P(a, b, c) __builtin_amdgcn_mfma_scale_f32_32x32x64_f8f6f4(a, b, c, 1, 0, 0, 0x70707070, 0, 0x7F7F7F7F)
#define MD_VF(VF, d0, t) do { const LAS unsigned char* vq_ = lds + D_VB + ((t) % 12) * 4096 + (r32 + 32 * (d0)) * 16 + hi * 2048; \
        const u32x4 c0_ = *(const LAS u32x4*)vq_, c1_ = *(const LAS u32x4*)(vq_ + 1024); \
        VF[0] = (int)c0_.x; VF[1] = (int)c0_.y; VF[2] = (int)c0_.z; VF[3] = (int)c0_.w; VF[4] = (int)c1_.x; VF[5] = (int)c1_.y; VF[6] = (int)c1_.z; VF[7] = (int)c1_.w; } while (0)
#define MD_PV(OO, PW, t) do { _Pragma("unroll") for (int d0 = 0; d0 < 2; ++d0) { i32x8 vf_; MD_VF(vf_, d0, t); OO[d0] = MFMA8P(PW, vf_, OO[d0]); } } while (0)
#define MD_SB() __builtin_amdgcn_sched_barrier(0)
    for (int t0 = 0; t0 < NT; t0 += 4) {
        const bool dma = (t0 + 8 < NT);
        if (dma) { MD_DMA(t0 + 8); MD_DMA(t0 + 9); MD_DMA(t0 + 10); MD_DMA(t0 + 11); }
#pragma unroll
        for (int tt = 0; tt < 4; ++tt) { const int t = t0 + tt;
        const bool needA = (t < NTA) && (t - 8 * p <= (qt >> 1)), needB = (t < NTA) || (t - NTA <= (qt >> 1));
        if (needA) {
            f32x16 a0, a1, b0, b1; i32x8 pwa, pwb;
            { const int kb_ = 64 * t; const bool sa_ = (selA >> (t >> 2)) & 1u, sb_ = (selB >> (t >> 2)) & 1u;
              const LAS float* ta_ = tbl + (sa_ ? (4095 - (qrowA - kb_) + 4 * hi) : (4096 + 4 * hi)); const LAS float* tb_ = tbl + (sb_ ? (4095 - (qrowB - kb_) + 4 * hi) : (4096 + 4 * hi));
#pragma unroll
              for (int r = 0; r < 16; ++r) { const int cc = (r & 3) + 8 * (r >> 2); a0[r] = ta_[cc]; a1[r] = ta_[cc + 32]; b0[r] = tb_[cc]; b1[r] = tb_[cc + 32]; }
              const LAS unsigned char* kq_ = lds + D_KB + (t % 12) * 4096 + r32 * 16 + hi * 8;
              i32x8 k0_, k1_;
#pragma unroll
              for (int d0 = 0; d0 < 4; ++d0) { const u32x2 x0_ = *(const LAS u32x2*)(kq_ + d0 * 1024), x1_ = *(const LAS u32x2*)(kq_ + d0 * 1024 + 512);
                  k0_[2 * d0] = (int)x0_.x; k0_[2 * d0 + 1] = (int)x0_.y; k1_[2 * d0] = (int)x1_.x; k1_[2 * d0 + 1] = (int)x1_.y; }
              a0 = MFMA8(k0_, q8A, a0); a1 = MFMA8(k1_, q8A, a1); b0 = MFMA8(k0_, q8B, b0); b1 = MFMA8(k1_, q8B, b1); }
            if (p == 0) MD_EXPX(pwa, a0, a1, onesA); else MD_EXP(pwa, a0, a1, onesA);
            MD_EXP(pwb, b0, b1, onesB);
#pragma unroll
            for (int d0 = 0; d0 < 2; ++d0) { i32x8 vf_; MD_VF(vf_, d0, t); oA[d0] = MFMA8P(pwa, vf_, oA[d0]); oB[d0] = MFMA8P(pwb, vf_, oB[d0]); }
        } else if (needB) {
            f32x16 b0, b1; i32x8 pwb;
            MD_QK(b0, b1, selB, qrowB, QB_, t); MD_EXP(pwb, b0, b1, onesB); MD_PV(oB, pwb, t);
        }
            __builtin_amdgcn_sched_barrier(0);
        }
        if (dma) asm volatile("s_waitcnt vmcnt(4) lgkmcnt(0)\n\ts_barrier" ::: "memory");
        else ATT_WAIT_BAR();
    }
    LAS bf16_t* stg = (LAS bf16_t*)(lds + D_OST) + wid * 2048;
    LAS float* wsf = (LAS float*)(lds + D_KM) + wid * 64;
#define MD_OUT(OO, OL, QB) do { const int lo_ = lane_id_v(), r3_ = lo_ & 31, h3_ = lo_ >> 5;        \
        if (r3_ == (OL)) { _Pragma("unroll") for (int r = 0; r < 16; ++r) wsf[crow(r, h3_)] = __builtin_amdgcn_rcpf(lacc[r]); } asm volatile("s_waitcnt lgkmcnt(0)" ::: "memory"); \
        _Pragma("unroll") for (int r = 0; r < 16; ++r) { const int orow = crow(r, h3_); const float sc = wsf[orow]; \
            _Pragma("unroll") for (int d0 = 0; d0 < 2; ++d0) stg[orow * 64 + d0 * 32 + r3_] = (bf16_t)(cvtpk(OO[d0][r] * sc, 0.f) & 0xffffu); } \
        asm volatile("s_waitcnt lgkmcnt(0)" ::: "memory"); \
        _Pragma("unroll") for (int i = 0; i < 4; ++i) { const int row = i * 8 + (lo_ >> 3), ch = lo_ & 7; const u32x4 v = *(const LAS u32x4*)(stg + row * 64 + ch * 8); \
            *(u32x4*)(O + (size_t)((QB) * 256 + qt * 32 + row) * 1024 + ch * 8) = v; } \
        asm volatile("s_waitcnt lgkmcnt(0)" ::: "memory"); } while (0)
    MD_OUT(oA, 0, qbA);
    MD_OUT(oB, 16, qbB);
    ATT_WAIT_BAR();
#undef MD_DMA
#undef MD_GATE
#undef MD_QK
#undef MD_EXP
#undef MD_EXPX
#undef U8X4
#undef MD_PV
#undef MD_VF
#undef MFMA8P
#undef MD_SB
#undef QA
#undef MFMA8
#undef QB_
#undef MD_OUT
}
}

constexpr int NWAVES = 8;
#ifndef MK_N_LAUNCHES
#define MK_N_LAUNCHES 1
#endif
constexpr int N_LAUNCHES = MK_N_LAUNCHES, PER_PHASE = 12;
constexpr size_t MiB = 1u << 20;
constexpr size_t WS_CTL = 0, CTL_ZERO_BYTES = 32 * 1024;
constexpr size_t WS_SS = 1 * MiB;
constexpr size_t WS_KM = WS_SS + 512 * 1024;
constexpr size_t WS_TBLB = 2 * MiB;
constexpr size_t WS_TBLA = WS_TBLB + 512 * 1024;
constexpr size_t WS_LA = 3 * MiB;
constexpr size_t WS_W = 6 * MiB;
constexpr size_t W_QKV0 = WS_W, W_O0 = W_QKV0 + 9 * MiB, W_QKV1 = W_O0 + 1 * MiB, W_O1 = W_QKV1 + 6 * MiB, W_UP0 = W_O1 + 2 * MiB, W_UP1 = W_UP0 + 8 * MiB, W_DN0 = W_UP1 + 8 * MiB, W_DN1 = W_DN0 + 8 * MiB;
constexpr size_t WS_HB = 56 * MiB;
constexpr size_t WS_OG = 56 * MiB;
constexpr size_t WS_HB8 = 88 * MiB;
constexpr size_t WS_W8 = 248 * MiB;
constexpr size_t WS_QKV = 104 * MiB;
constexpr size_t WS_O0 = 104 * MiB;
constexpr size_t WS_O1 = 200 * MiB;
constexpr size_t WS_H = 104 * MiB;
constexpr size_t WS_END = 256 * MiB;
static_assert(W_DN1 + 8 * MiB == WS_HB && WS_H + 128 * MiB <= WS_END && WS_QKV + 144 * MiB <= WS_END, "d_ws map");
constexpr int CW_BAR = 4096;
constexpr int RING_BYTES = 131072, LDS_BYTES = 163840, LDSCTL_OFF = LDS_BYTES - 512, MISC_OFF = LDSCTL_OFF + 320;
static_assert(att::S_END <= LDSCTL_OFF && att::D_END <= LDSCTL_OFF, "attention LDS");

typedef GAS unsigned gu32;
#define RLX_AGENT __ATOMIC_RELAXED, __HIP_MEMORY_SCOPE_AGENT
#define XB_TMO      128
#define XB_XCNT(j)  (256  + 64 * (j))
#define XB_XSUB(j)  (1280 + 64 * (j))
#define XB_XGEN(j)  (2304 + 64 * (j))
#define XB_TOP      3328
#define XB_TOPGEN   3392
#define XCD_BAR_WORDS 3456
#define XB_SPIN_CAP (1u << 18)
__device__ __forceinline__ unsigned xb_ld(unsigned* p)              { return __hip_atomic_load(p, __ATOMIC_RELAXED, __HIP_MEMORY_SCOPE_AGENT); }
__device__ __forceinline__ unsigned xb_add(unsigned* p, unsigned v) { return __hip_atomic_fetch_add(p, v, __ATOMIC_RELAXED, __HIP_MEMORY_SCOPE_AGENT); }
__device__ __forceinline__ unsigned xb_xcc_id() { return (unsigned)__builtin_amdgcn_s_getreg((3 << 11) | 20) & 0xFu; }
#define XB_SPIN(cond, bar) do { unsigned _sp = 0; while (cond) { __builtin_amdgcn_s_sleep(1); \
    if ((++_sp & 255u) == 0u) { if (xb_ld(&(bar)[XB_TMO])) break; if (_sp > XB_SPIN_CAP) { atomicAdd(&(bar)[XB_TMO], 1u); break; } } } } while (0)
struct XcdBarrier { unsigned* bar; unsigned x; volatile LAS unsigned* st; };
__device__ __forceinline__ XcdBarrier xcd_barrier_post(unsigned* bar, volatile LAS unsigned* st) {
    XcdBarrier b; b.bar = bar; b.x = xb_xcc_id(); b.st = st;
    if (threadIdx.x == 0) (void)xb_add(&bar[XB_XCNT(b.x)], 1u);
    return b;
}
__device__ __forceinline__ void xcd_barrier_complete(unsigned* bar, unsigned x, unsigned& nloc, unsigned& nx) {
    const unsigned G = gridDim.x * gridDim.y * gridDim.z;
    unsigned sum, cnt, mine, sp = 0u;
    for (;;) {
        sum = 0u; cnt = 0u; mine = 0u;
#pragma unroll
        for (unsigned j = 0; j < 16; ++j) { const unsigned c = xb_ld(&bar[XB_XCNT(j)]); sum += c; cnt += (c > 0u) ? 1u : 0u; mine = (j == x) ? c : mine; }
        if (sum == G) break;
        __builtin_amdgcn_s_sleep(1);
        if ((++sp & 255u) == 0u) { if (xb_ld(&bar[XB_TMO])) break; if (sp > XB_SPIN_CAP) { atomicAdd(&bar[XB_TMO], 1u); break; } }
    }
    nloc = mine > 0u ? mine : 1u; nx = cnt > 0u ? cnt : 1u;
}
__device__ __forceinline__ void xcd_barrier(const XcdBarrier& b) {
    asm volatile("s_waitcnt vmcnt(0)" ::: "memory");
    __syncthreads();
    if (threadIdx.x == 0) {
        unsigned* bar = b.bar;
        __builtin_amdgcn_s_waitcnt(0);
        unsigned nloc = b.st[0], nx = b.st[1];
        if (nloc == 0u) { xcd_barrier_complete(bar, b.x, nloc, nx); b.st[0] = nloc; b.st[1] = nx; }
        const unsigned old = xb_add(&bar[XB_XSUB(b.x)], 1u);
        const unsigned gen = old / nloc;
        if (old + 1u == (gen + 1u) * nloc) {
            __builtin_amdgcn_fence(__ATOMIC_RELEASE, "agent");
            asm volatile("s_waitcnt vmcnt(0)" ::: "memory");
            const unsigned og = xb_add(&bar[XB_TOP], 1u);
            const unsigned tg = og / nx;
            if (og + 1u == (tg + 1u) * nx) xb_add(&bar[XB_TOPGEN], 1u);
            else XB_SPIN(xb_ld(&bar[XB_TOPGEN]) == tg, bar);
            __builtin_amdgcn_fence(__ATOMIC_ACQUIRE, "agent");
            xb_add(&bar[XB_XGEN(b.x)], 1u);
            asm volatile("s_waitcnt vmcnt(0)" ::: "memory");
        } else {
            XB_SPIN(xb_ld(&bar[XB_XGEN(b.x)]) == gen, bar);
            __builtin_amdgcn_fence(__ATOMIC_ACQUIRE, "agent");
            asm volatile("s_waitcnt vmcnt(0)" ::: "memory");
        }
    }
    __syncthreads();
}

__device__ __forceinline__ float wave_sum(float v) {
#pragma unroll
    for (int o = 1; o < 64; o <<= 1) v += __shfl_xor(v, o);
    return v;
}
__device__ __forceinline__ float wave_max(float v) {
#pragma unroll
    for (int o = 1; o < 64; o <<= 1) v = fmaxf(v, __shfl_xor(v, o));
    return v;
}
__device__ __forceinline__ void p0_transpose_item(const float* W, int K, int N, bf16_t* WT, const float* gain, bool perm, LAS float* scr, int item, int lane, unsigned char* WT8 = nullptr, int n8 = 0) {
    const int nblk = N / 32, kb = item / nblk, nb = item % nblk, k0 = 64 * kb, n0 = 32 * nb;
    const int kr = lane >> 3, c4 = (lane & 7) * 4;
    f32x4 v[8]; float gs[8];
#pragma unroll
    for (int i = 0; i < 8; ++i) { v[i] = *(const f32x4*)(W + (size_t)(k0 + 8 * i + kr) * N + n0 + c4); gs[i] = gain ? gain[k0 + 8 * i + kr] : 1.f; }
#pragma unroll
    for (int i = 0; i < 8; ++i) { LAS float* s = scr + (8 * i + kr) * 33 + c4; s[0] = v[i][0] * gs[i]; s[1] = v[i][1] * gs[i]; s[2] = v[i][2] * gs[i]; s[3] = v[i][3] * gs[i]; }
    asm volatile("s_waitcnt lgkmcnt(0)" ::: "memory");
    const int c = lane & 7;
    const int orow0 = perm ? ((n0 & ~255) + ((n0 >> 5) & 1) * 128 + ((n0 >> 6) & 3) * 32) : n0;
#pragma unroll
    for (int j = 0; j < 4; ++j) { const int n = (lane >> 3) + 8 * j; const LAS float* s = scr + (8 * c) * 33 + n;
        if (n0 < n8) { u32x2 o8; o8.x = pk4_fp8(s[0 * 33] * 32.f, s[1 * 33] * 32.f, s[2 * 33] * 32.f, s[3 * 33] * 32.f); o8.y = pk4_fp8(s[4 * 33] * 32.f, s[5 * 33] * 32.f, s[6 * 33] * 32.f, s[7 * 33] * 32.f);
            *(u32x2*)(WT8 + (size_t)(orow0 + n) * K + k0 + 8 * c) = o8; }
        { u32x4 o; o.x = cvtpk(s[0 * 33], s[1 * 33]); o.y = cvtpk(s[2 * 33], s[3 * 33]); o.z = cvtpk(s[4 * 33], s[5 * 33]); o.w = cvtpk(s[6 * 33], s[7 * 33]);
            *(u32x4*)(WT + (size_t)(orow0 + n) * K + k0 + 8 * c) = o; } }
    asm volatile("s_waitcnt lgkmcnt(0)" ::: "memory");
}
__device__ __forceinline__ int t5_bucket(int n) {
    if (n < 16) return n;
    const int thr[15] = {22, 30, 40, 54, 73, 99, 134, 182, 246, 332, 450, 609, 825, 1117, 1513};
    int b = 16;
#pragma unroll
    for (int k = 0; k < 15; ++k) b += (n >= thr[k]) ? 1 : 0;
    return b;
}

struct Args { const float* in[14]; float* out; unsigned char* ws; int ph_lo, ph_hi, li, pad; };

__global__ void __launch_bounds__(NWAVES * 64, 2) hybrid_fwd(Args args) {
    extern __shared__ __attribute__((aligned(16))) unsigned char lds_raw[];
    LAS unsigned char* lds = (LAS unsigned char*)lds_raw;
    volatile LAS unsigned* MISC = (volatile LAS unsigned*)(lds + MISC_OFF);
    const int tid = threadIdx.x, lane = tid & 63, wave = __builtin_amdgcn_readfirstlane(tid >> 6);
    const int G = gridDim.x, bx = blockIdx.x, vcu = (G % 8 == 0) ? (bx % 8) * (G / 8) + bx / 8 : bx;
    unsigned char* ws = args.ws;
    unsigned* ctl = (unsigned*)(ws + WS_CTL);
    const float* x = args.in[0]; const float* rel_bias = args.in[1]; const float* norm_mix = args.in[2]; const float* norm_ffn = args.in[3];
    const float* a_w_qkv = args.in[4]; const float* a_q_gain = args.in[5]; const float* a_k_gain = args.in[6]; const float* a_w_o = args.in[7];
    const float* b_w_qkv = args.in[8]; const float* b_q_gain = args.in[9]; const float* b_k_gain = args.in[10]; const float* b_w_o = args.in[11];
    const float* ffn_w1 = args.in[12]; const float* ffn_w2 = args.in[13];
    float* out = args.out;
    float* ssp = (float*)(ws + WS_SS); float* kmp = (float*)(ws + WS_KM); float* tblB = (float*)(ws + WS_TBLB); float* tblA = (float*)(ws + WS_TBLA); float* la = (float*)(ws + WS_LA);
    bf16_t* HB = (bf16_t*)(ws + WS_HB); bf16_t* OG = (bf16_t*)(ws + WS_OG); bf16_t* QKV = (bf16_t*)(ws + WS_QKV); bf16_t* O0 = (bf16_t*)(ws + WS_O0); bf16_t* O1 = (bf16_t*)(ws + WS_O1); bf16_t* HH = (bf16_t*)(ws + WS_H);

    for (int u = tid; u < (LDS_BYTES - LDSCTL_OFF) / 4; u += NWAVES * 64) ((LAS unsigned*)(lds + LDSCTL_OFF))[u] = 0u;
    __syncthreads();
    XcdBarrier bar; bar.bar = ctl + CW_BAR; bar.x = 0; bar.st = nullptr;
    if (N_LAUNCHES != PER_PHASE) bar = xcd_barrier_post(ctl + CW_BAR, MISC + 8);
#define GRID_BAR() do { if (N_LAUNCHES != PER_PHASE) xcd_barrier(bar); } while (0)
    const int lo = args.ph_lo, hi = args.ph_hi;
#define IN(k) (lo <= (k) && (k) < hi)
#define BOTH(k) (IN(k) && IN((k) + 1))

    constexpr int I0 = (DM / 64) * (NQKV0 / 32), I1 = (NO0 / 64) * (DM / 32), I2 = (DM / 64) * (NQKV1 / 32), I3 = (NO1 / 64) * (DM / 32), I4 = (DM / 64) * (FF / 32), I5 = (FF / 64) * (DM / 32);
    constexpr int NITEMS_A = I0 + I1, NITEMS = NITEMS_A + I4 + I5 + I2 + I3 + I4 + I5;
#define P0_ITEM(it_) do { int r = (it_); LAS float* scr_ = (LAS float*)(lds + wave * 16384); \
        if (r < I0) { p0_transpose_item(a_w_qkv, DM, NQKV0, (bf16_t*)(ws + W_QKV0), norm_mix, true, scr_, r, lane, ws + WS_W8, 4608); break; } r -= I0; \
        if (r < I1) { p0_transpose_item(a_w_o, NO0, DM, (bf16_t*)(ws + W_O0), nullptr, false, scr_, r, lane); break; } r -= I1; \
        if (r < I4) { p0_transpose_item(ffn_w1, DM, FF, (bf16_t*)(ws + W_UP0), norm_ffn, false, scr_, r, lane); break; } r -= I4; \
        if (r < I5) { p0_transpose_item(ffn_w2, FF, DM, (bf16_t*)(ws + W_DN0), nullptr, false, scr_, r, lane); break; } r -= I5; \
        if (r < I2) { p0_transpose_item(b_w_qkv, DM, NQKV1, (bf16_t*)(ws + W_QKV1), norm_mix + DM, (r % (NQKV1 / 32)) < 64  , scr_, r, lane); break; } r -= I2; \
        if (r < I3) { p0_transpose_item(b_w_o, NO1, DM, (bf16_t*)(ws + W_O1), nullptr, false, scr_, r, lane); break; } r -= I3; \
        if (r < I4) { p0_transpose_item(ffn_w1 + (size_t)DM * FF, DM, FF, (bf16_t*)(ws + W_UP1), norm_ffn + DM, false, scr_, r, lane); break; } r -= I4; \
        p0_transpose_item(ffn_w2 + (size_t)FF * DM, FF, DM, (bf16_t*)(ws + W_DN1), nullptr, false, scr_, r, lane); } while (0)
    if (IN(0)) {
        const int gw = vcu * NWAVES + wave, NGW = G * NWAVES;
        for (int it = gw; it < NITEMS_A; it += NGW) P0_ITEM(it);
        for (int m = 2 * gw; m < MTOK; m += 2 * NGW) {
            f32x4 v[2][4]; float s[2] = {0.f, 0.f};
#pragma unroll
            for (int q = 0; q < 2; ++q)
#pragma unroll
                for (int j = 0; j < 2; ++j) { const f32x4* xp = (const f32x4*)(x + (size_t)(m + q) * DM + 512 * j + 8 * lane); v[q][2 * j] = xp[0]; v[q][2 * j + 1] = xp[1]; }
#pragma unroll
            for (int q = 0; q < 2; ++q) {
#pragma unroll
                for (int j = 0; j < 4; ++j) s[q] += (v[q][j][0] * v[q][j][0] + v[q][j][1] * v[q][j][1]) + (v[q][j][2] * v[q][j][2] + v[q][j][3] * v[q][j][3]);
                s[q] = wave_sum(s[q]);
#pragma unroll
                for (int j = 0; j < 2; ++j) { u32x4 w; w.x = cvtpk(v[q][2 * j][0], v[q][2 * j][1]); w.y = cvtpk(v[q][2 * j][2], v[q][2 * j][3]); w.z = cvtpk(v[q][2 * j + 1][0], v[q][2 * j + 1][1]); w.w = cvtpk(v[q][2 * j + 1][2], v[q][2 * j + 1][3]);
                    if (((m + q) & 4095) < 256) *(u32x4*)(HB + (size_t)(m + q) * DM + 512 * j + 8 * lane) = w;
                    u32x2 w8; w8.x = pk4_fp8(v[q][2 * j][0], v[q][2 * j][1], v[q][2 * j][2], v[q][2 * j][3]); w8.y = pk4_fp8(v[q][2 * j + 1][0], v[q][2 * j + 1][1], v[q][2 * j + 1][2], v[q][2 * j + 1][3]);
                    *(u32x2*)(ws + WS_HB8 + (size_t)(m + q) * DM + 512 * j + 8 * lane) = w8; }
                if (lane == 0) *(f32x4*)(ssp + (size_t)(m + q) * 4) = (f32x4){s[q], 0.f, 0.f, 0.f};
            }
        }
        {
            float mb = 0.f;
            for (int i = lane; i < 32 * 24; i += 64) mb = fmaxf(mb, rel_bias[i]);
            mb = wave_max(mb);
            const float refA = (8.f * wave_max(fabsf(a_q_gain[lane])) * wave_max(fabsf(a_k_gain[lane])) + mb) * LOG2E;
            const float refB = (8.f * wave_max(fabsf(b_q_gain[lane])) * wave_max(fabsf(b_k_gain[lane])) + mb) * LOG2E;
            const int gt = vcu * 512 + tid, NGT = G * 512;
            for (int e = gt; e < 16 * TBLB_N; e += NGT) { const int h = e / TBLB_N, idx = e % TBLB_N, dist = 4095 - idx;
                tblB[e] = (dist < 0) ? NEGV : 4.f * (rel_bias[t5_bucket(dist) * 24 + h] * LOG2E - refB) + 116.f; }
            for (int e = gt; e < 24 * TBLA_N; e += NGT) { const int col = e / TBLA_N, idx = e % TBLA_N, dist = 383 - idx, g = col >> 3;
                tblA[e] = (dist < 0 || dist > 128) ? NEGV : rel_bias[t5_bucket(dist << (2 * g)) * 24 + col] * LOG2E - refA; }
        }
        if (BOTH(0)) GRID_BAR();
    }
    if (IN(1)) {
        {
            pg8::Gemm g{(const bf16_t*)(ws + WS_HB8), (const bf16_t*)(ws + WS_W8), MTOK, 4608, DM / 2}; pg8::SkipFirstPanelOrder S; S.init(G, bx);
            pg8::EpiQKV E{0, ssp, a_q_gain, a_k_gain, QKV, nullptr, 0};
            pg8::gemm_phase<pg8::EpiQKV, pg8::SkipFirstPanelOrder, true, true, true>(lds, g, S, E); }
        {
            pg8::Gemm g{HB, (const bf16_t*)(ws + W_QKV0), MTOK, 4608, DM}; pg8::FirstPanelOrder S; S.init(G, bx);
            pg8::EpiQKV E{0, ssp, a_q_gain, a_k_gain, QKV, nullptr, 0};
            pg8::gemm_phase<pg8::EpiQKV, pg8::FirstPanelOrder, true, true>(lds, g, S, E); }
        {
            const int lo = 1080 % G, hi_ = G - 72;
            if (bx >= lo && bx < hi_) { const int iw = (bx - lo) * NWAVES + wave, NIW = (hi_ - lo) * NWAVES;
                for (int it = NITEMS_A + iw; it < NITEMS; it += NIW) P0_ITEM(it); } }
        if (BOTH(1)) GRID_BAR();
    }
    if (IN(2)) {
        const int nit = 768, perw = (nit + G - 1) / G;
        for (int k = 0; k < 3; ++k) {
            int item;
            if (G == 256) item = (k == 0) ? vcu : 256 + 2 * vcu + (k - 1);
            else { item = vcu * perw + k; if (k >= perw || item >= nit) break; }
            int g, sq, i0, R;
            if (item < 128) { g = 0; sq = item >> 2; i0 = (item & 3) * 32; R = 4; }
            else if (item < 256) { g = 1; sq = item - 128; i0 = 0; R = 4; }
            else { g = 2; sq = item - 256; i0 = 0; R = 1; }
            const int sh = 2 * g, dil = 1 << sh, Lg = SEQ >> sh, hh = sq & 7, vb = sq >> 3, b = vb >> sh, c = vb & (dil - 1);
            att::StreamDesc U;
            const size_t seqoff = (size_t)sq * Lg * 64;
            U.Q = QKV + (size_t)(0 * 3 + g) * ((size_t)MTOK * 512) + seqoff; U.K = (const bf16_t*)((const unsigned char*)(QKV + (size_t)(1 * 3 + g) * ((size_t)MTOK * 512)) + seqoff);       U.V = QKV + (size_t)(2 * 3 + g) * ((size_t)MTOK * 512) + seqoff;
            U.i0 = i0; U.R = R; U.tblg = tblA + (size_t)(g * 8 + hh) * TBLA_N;
            U.O = OG + (size_t)g * ((size_t)MTOK * 512) + hh * 64; U.o_row0 = b * SEQ + c; U.o_rstride = dil;
            U.L = la + (size_t)g * ((size_t)MTOK * 8) + hh;
            att::stream(lds, U);
        }
        if (BOTH(2)) GRID_BAR();
    }
    if (IN(3)) {
        const int gt = vcu * 512 + tid, NGT = G * 512;
        for (int e = gt; e < MTOK * 64; e += NGT) {
            const int row = e >> 6, c8 = e & 63, hh = c8 >> 3;
            float acc8[8] = {0.f, 0.f, 0.f, 0.f, 0.f, 0.f, 0.f, 0.f}; float l = 0.f;
#pragma unroll
            for (int g = 0; g < 3; ++g) { const u32x4 w = *(const u32x4*)(OG + (size_t)g * ((size_t)MTOK * 512) + (size_t)row * 512 + c8 * 8);
                l += la[(size_t)g * ((size_t)MTOK * 8) + (size_t)row * 8 + hh];
#pragma unroll
                for (int k = 0; k < 4; ++k) { acc8[2 * k] += __builtin_bit_cast(float, w[k] << 16); acc8[2 * k + 1] += __builtin_bit_cast(float, w[k] & 0xffff0000u); } }
            const float rl = 1.f / l; u32x4 o;
            o.x = cvtpk(acc8[0] * rl, acc8[1] * rl); o.y = cvtpk(acc8[2] * rl, acc8[3] * rl); o.z = cvtpk(acc8[4] * rl, acc8[5] * rl); o.w = cvtpk(acc8[6] * rl, acc8[7] * rl);
            *(u32x4*)(O0 + (size_t)row * 512 + c8 * 8) = o;
        }
        if (BOTH(3)) GRID_BAR();
    }
    if (IN(4)) {
        pg8::Gemm g{O0, (const bf16_t*)(ws + W_O0), MTOK, DM, NO0}; pg8::StaticOrder S; S.init(MTOK, DM, G, bx);
        pg8::EpiRes<0> E{x, out, HB, ssp};
        pg8::gemm_phase<pg8::EpiRes<0>, pg8::StaticOrder, false, true>(lds, g, S, E);
        if (BOTH(4)) GRID_BAR();
    }
#define UP_PHASE(PU, WUP) \
    if (IN(PU)) { pg8::Gemm g{HB, (const bf16_t*)(ws + (WUP)), MTOK, FF, DM}; pg8::StaticOrder S; S.init(MTOK, FF, G, bx); pg8::EpiUp E{ssp, HH}; \
        pg8::gemm_phase<pg8::EpiUp, pg8::StaticOrder, true, true>(lds, g, S, E); if (BOTH(PU)) GRID_BAR(); }
#define DN_PHASE(PD, WDN, MODE) \
    if (IN(PD)) { pg8::Gemm g{HH, (const bf16_t*)(ws + (WDN)), MTOK, DM, FF}; pg8::StaticOrder S; S.init(MTOK, DM, G, bx); pg8::EpiRes<MODE> E{nullptr, out, HB, ssp}; \
        pg8::gemm_phase<pg8::EpiRes<MODE>, pg8::StaticOrder, false, true>(lds, g, S, E); if (BOTH(PD)) GRID_BAR(); }
    UP_PHASE(5, W_UP0)
    DN_PHASE(6, W_DN0, 1)
    if (IN(7)) {
        {
            constexpr long PANEL = 256l * DM * 2;
            constexpr int VT_PM0 = (int)(((long)(W_QKV1 + (size_t)2048 * DM * 2) - (long)WS_HB) / PANEL), VT_PN0 = (int)(((long)WS_HB - (long)W_QKV1) / PANEL);
            static_assert((long)WS_HB + (long)VT_PM0 * PANEL == (long)(W_QKV1 + (size_t)2048 * DM * 2) && (long)W_QKV1 + (long)VT_PN0 * PANEL == (long)WS_HB && VT_PN0 > 8, "V^T unit offsets");
            pg8::Gemm g{HB, (const bf16_t*)(ws + W_QKV1), MTOK, 2048, DM}; pg8::QKVTOrder S; S.init(MTOK, G, bx, VT_PM0, VT_PN0);
            pg8::EpiQKVT E{pg8::EpiQKV{1, ssp, b_q_gain, b_k_gain, QKV, kmp}, pg8::EpiVT{ssp, (unsigned char*)(QKV + (size_t)2 * MTOK * 1024)}, VT_PM0, VT_PN0};
            pg8::gemm_phase<pg8::EpiQKVT, pg8::QKVTOrder, true, true>(lds, g, S, E); }
        if (BOTH(7)) GRID_BAR();
    }
    if (IN(8)) {
        const int per = (512 + G - 1) / G;
        for (int i = 0; i < per; ++i) {
            int bh, p;
            if (per == 2) { const int s = vcu & 3; bh = vcu >> 2; p = (i == 0) ? s : 7 - s; }
            else { const int uid = vcu * per + i; if (uid >= 512) break; bh = uid >> 3; p = uid & 7; }
            const int b = bh >> 4, h = bh & 15;
            const size_t seqoff = (size_t)bh * SEQ * 64;
            att::moba_pair(lds, p, QKV + seqoff, (const bf16_t*)((const unsigned char*)(QKV + (size_t)MTOK * 1024) + seqoff), (const bf16_t*)((const unsigned char*)(QKV + (size_t)2 * MTOK * 1024) + seqoff), tblB + (size_t)h * TBLB_N,
                           kmp + (((size_t)0 * BATCH + b) * 16 * 16 + h) * 64, kmp + (((size_t)1 * BATCH + b) * 16 * 16 + h) * 64, O1 + (size_t)(b * SEQ) * 1024 + h * 64);
        }
        if (BOTH(8)) GRID_BAR();
    }
    if (IN(9)) {
        pg8::Gemm g{O1, (const bf16_t*)(ws + W_O1), MTOK, DM, NO1}; pg8::StaticOrder S; S.init(MTOK, DM, G, bx);
        pg8::EpiRes<1> E{nullptr, out, HB, ssp};
        pg8::gemm_phase<pg8::EpiRes<1>, pg8::StaticOrder, false, true>(lds, g, S, E);
        if (BOTH(9)) GRID_BAR();
    }
    UP_PHASE(10, W_UP1)
    DN_PHASE(11, W_DN1, 2)
#undef IN
#undef BOTH
}

extern "C" void kernel_launch(void* const* d_in, const int* in_sizes, int n_in, void* d_out, int out_size, void* d_ws, size_t ws_size, hipStream_t stream) {
    static int grid = 0;
    if (grid == 0) {
        if (n_in != 14 || in_sizes[0] != MTOK * DM || out_size != MTOK * DM || ws_size < WS_END) { fprintf(stderr, "kernel_launch: unexpected shapes (n_in %d, in0 %d, out %d, ws %zu); nothing launched\n", n_in, n_in > 0 ? in_sizes[0] : -1, out_size, ws_size); grid = -1; return; }
        int dev = 0, cus = 0, per_cu = 0;
        if (hipGetDevice(&dev) != hipSuccess || hipDeviceGetAttribute(&cus, hipDeviceAttributeMultiprocessorCount, dev) != hipSuccess) { fprintf(stderr, "kernel_launch: device query failed\n"); grid = -1; return; }
        if (hipFuncSetAttribute((const void*)hybrid_fwd, hipFuncAttributeMaxDynamicSharedMemorySize, LDS_BYTES) != hipSuccess) { fprintf(stderr, "kernel_launch: hipFuncSetAttribute failed\n"); grid = -1; return; }
        if (hipOccupancyMaxActiveBlocksPerMultiprocessor(&per_cu, (const void*)hybrid_fwd, NWAVES * 64, LDS_BYTES) != hipSuccess || per_cu < 1) fprintf(stderr, "kernel_launch: note: occupancy query reports %d workgroups per CU\n", per_cu);
        (void)hipGetLastError();
        grid = cus;
        if (grid != 256) { fprintf(stderr, "kernel_launch: built for a 256-CU device, found %d CUs; nothing launched\n", cus); grid = -1; return; }
    }
    if (grid < 0) return;
    if (hipMemsetAsync((char*)d_ws + WS_CTL, 0, CTL_ZERO_BYTES, stream) != hipSuccess) { fprintf(stderr, "kernel_launch: hipMemsetAsync failed\n"); return; }
    Args a{};
    for (int i = 0; i < 14; ++i) a.in[i] = (const float*)d_in[i];
    a.out = (float*)d_out; a.ws = (unsigned char*)d_ws;
    if (N_LAUNCHES == 1) { a.ph_lo = 0; a.ph_hi = PER_PHASE; a.li = 0; hipLaunchKernelGGL(hybrid_fwd, dim3(grid), dim3(NWAVES * 64), LDS_BYTES, stream, a); }
    else for (int li = 0; li < PER_PHASE; ++li) { a.ph_lo = li; a.ph_hi = li + 1; a.li = li; hipLaunchKernelGGL(hybrid_fwd, dim3(grid), dim3(NWAVES * 64), LDS_BYTES, stream, a); }
    const hipError_t le = hipPeekAtLastError();
    if (le != hipSuccess) fprintf(stderr, "kernel_launch: launch failed: %s\n", hipGetErrorName(le));
}
```
